# Optimizing an MI355X kernel written in HIP

```python
import math
import jax, jax.numpy as jnp
from jax import lax
import numpy as np

D_MODEL = 1024
BATCH = 8
SEQ = 4096
DEPTH = 2

HEAD_DIM = 64
N_HEADS_A = D_MODEL // HEAD_DIM
N_HEADS_B = D_MODEL // HEAD_DIM
N_KV_B = 4
GROUP_B = N_HEADS_B // N_KV_B
D_FF = 2816
DILATED_PATTERNS = ((128, 1), (512, 4), (2048, 16))
WINDOW_B = 128
BLOCK = 128
N_A_LAYERS = DEPTH // 2
N_B_LAYERS = DEPTH - N_A_LAYERS
ALPHA = (2.0 * DEPTH) ** 0.25
BETA = (8.0 * DEPTH) ** -0.25
LN_EPS = 1e-5

kernel_name = "yoco_dilated_swa_sink_hybrid"


def alibi_slopes(n):
    return np.array([2.0 ** (-8.0 * (h + 1) / n) for h in range(n)], dtype=np.float32)


def layer_norm(x, g, b):
    xf = x.astype(jnp.float32)
    mu = xf.mean(-1, keepdims=True)
    var = jnp.mean(jnp.square(xf - mu), -1, keepdims=True)
    y = (xf - mu) * lax.rsqrt(var + LN_EPS) * g.astype(jnp.float32) + b.astype(jnp.float32)
    return y.astype(x.dtype)


def swiglu(x, w_in, w_out):
    gate, up = jnp.split(x @ w_in, 2, axis=-1)
    return (jax.nn.silu(gate) * up) @ w_out


def banded_attention(q, k, v, slopes, max_dist, dist_scale, sinks=None):
    b, L, hk, g, dh = q.shape
    P = BLOCK
    nb = -(-L // P)
    pad = nb * P - L
    if pad:
        q = jnp.pad(q, ((0, 0), (0, pad), (0, 0), (0, 0), (0, 0)))
        k = jnp.pad(k, ((0, 0), (0, pad), (0, 0), (0, 0)))
        v = jnp.pad(v, ((0, 0), (0, pad), (0, 0), (0, 0)))
    qb = q.reshape(b, nb, P, hk, g, dh)

    def with_prev(t):
        t = t.reshape(b, nb, P, hk, dh)
        prev = jnp.concatenate([jnp.zeros_like(t[:, :1]), t[:, :-1]], axis=1)
        return jnp.concatenate([prev, t], axis=2)

    kc, vc = with_prev(k), with_prev(v)
    s = jnp.einsum('bnqhgd,bnkhd->bnhgqk', qb.astype(jnp.float32), kc.astype(jnp.float32)) * (dh ** -0.5)
    qi = np.arange(P)[:, None]
    kj = np.arange(2 * P)[None, :]
    dist = P + qi - kj
    kpos = (np.arange(nb)[:, None, None] - 1) * P + kj[None]
    valid = (dist >= 0) & (dist <= max_dist) & (kpos >= 0)
    bias = -(slopes.astype(jnp.float32)[:, :, None, None]
             * jnp.asarray((dist * dist_scale).astype(np.float32)))
    s = jnp.where(jnp.asarray(valid)[None, :, None, None], s + bias, -jnp.inf)
    m = s.max(-1, keepdims=True)
    if sinks is not None:
        sink = sinks.astype(jnp.float32)[:, :, None, None]
        m = jnp.maximum(m, sink)
    p = jnp.exp(s - m)
    den = p.sum(-1, keepdims=True)
    if sinks is not None:
        den = den + jnp.exp(sink - m)
    o = jnp.einsum('bnhgqk,bnkhd->bnqhgd', p / den, vc.astype(jnp.float32))
    lse = jnp.moveaxis((m + jnp.log(den))[..., 0], -1, 2)
    o = o.reshape(b, nb * P, hk, g, dh)[:, :L].astype(q.dtype)
    lse = lse.reshape(b, nb * P, hk, g)[:, :L]
    return o, lse


def to_strided(t, d):
    b, S = t.shape[:2]
    t = t.reshape(b, S // d, d, *t.shape[2:])
    t = jnp.moveaxis(t, 2, 1)
    return t.reshape(b * d, S // d, *t.shape[3:])


def from_strided(t, b, d):
    t = t.reshape(b, d, *t.shape[1:])
    t = jnp.moveaxis(t, 1, 2)
    return t.reshape(b, t.shape[1] * d, *t.shape[3:])


def dilated_mixer(h, w_qkv, w_o):
    b, S, _ = h.shape
    q, k, v = jnp.split(h @ w_qkv, 3, axis=-1)
    q = q.reshape(b, S, N_HEADS_A, 1, HEAD_DIM)
    k = k.reshape(b, S, N_HEADS_A, HEAD_DIM)
    v = v.reshape(b, S, N_HEADS_A, HEAD_DIM)
    slopes = jnp.asarray(alibi_slopes(N_HEADS_A)).reshape(N_HEADS_A, 1)
    outs, lses = [], []
    for window, d in DILATED_PATTERNS:
        o, lse = banded_attention(to_strided(q, d), to_strided(k, d), to_strided(v, d),
                                  slopes, window // d, d)
        outs.append(from_strided(o, b, d))
        lses.append(from_strided(lse, b, d))
    wts = jax.nn.softmax(jnp.stack(lses, 0), axis=0)
    out = jnp.sum(wts[..., None] * jnp.stack(outs, 0).astype(jnp.float32), axis=0)
    return out.astype(h.dtype).reshape(b, S, D_MODEL) @ w_o


def swa_sink_mixer(h, k_sh, v_sh, w_q, sinks, w_o):
    b, S, _ = h.shape
    q = (h @ w_q).reshape(b, S, N_KV_B, GROUP_B, HEAD_DIM)
    slopes = jnp.asarray(alibi_slopes(N_HEADS_B)).reshape(N_KV_B, GROUP_B)
    o, _ = banded_attention(q, k_sh, v_sh, slopes, WINDOW_B - 1, 1,
                            sinks.reshape(N_KV_B, GROUP_B))
    return o.reshape(b, S, D_MODEL) @ w_o


def setup_inputs(seed: int = 0) -> dict:
    key = jax.random.key(seed)
    ks = jax.random.split(key, 16)
    f32 = jnp.float32
    nrm = lambda k, shape, fan_in, scale=1.0: jax.random.normal(k, shape, f32) * (fan_in ** -0.5) * scale
    return {
        "x": jax.random.normal(ks[0], (BATCH, SEQ, D_MODEL), f32),
        "ffn1_w_in": nrm(ks[1], (DEPTH, D_MODEL, 2 * D_FF), D_MODEL),
        "ffn1_w_out": nrm(ks[2], (DEPTH, D_FF, D_MODEL), D_FF, BETA),
        "ffn2_w_in": nrm(ks[3], (DEPTH, D_MODEL, 2 * D_FF), D_MODEL),
        "ffn2_w_out": nrm(ks[4], (DEPTH, D_FF, D_MODEL), D_FF, BETA),
        "ln_g": 1.0 + 0.02 * jax.random.normal(ks[5], (DEPTH, 3, D_MODEL), f32),
        "ln_b": 0.02 * jax.random.normal(ks[6], (DEPTH, 3, D_MODEL), f32),
        "a_w_qkv": nrm(ks[7], (N_A_LAYERS, D_MODEL, 3 * N_HEADS_A * HEAD_DIM), D_MODEL),
        "a_w_o": nrm(ks[8], (N_A_LAYERS, N_HEADS_A * HEAD_DIM, D_MODEL), D_MODEL, BETA),
        "kv_w": nrm(ks[9], (D_MODEL, 2 * N_KV_B * HEAD_DIM), D_MODEL),
        "b_w_q": nrm(ks[10], (N_B_LAYERS, D_MODEL, N_HEADS_B * HEAD_DIM), D_MODEL),
        "b_sinks": 0.5 * jax.random.normal(ks[11], (N_B_LAYERS, N_HEADS_B), f32),
        "b_w_o": nrm(ks[12], (N_B_LAYERS, N_HEADS_B * HEAD_DIM, D_MODEL), D_MODEL, BETA),
    }


def reference(x, ffn1_w_in, ffn1_w_out, ffn2_w_in, ffn2_w_out, ln_g, ln_b,
              a_w_qkv, a_w_o, kv_w, b_w_q, b_sinks, b_w_o):
    b, S, _ = x.shape
    k_sh = v_sh = None
    for i in range(DEPTH):
        x = layer_norm(ALPHA * x + 0.5 * swiglu(x, ffn1_w_in[i], ffn1_w_out[i]), ln_g[i, 0], ln_b[i, 0])
        if i < N_A_LAYERS:
            mix = dilated_mixer(x, a_w_qkv[i], a_w_o[i])
        else:
            j = i - N_A_LAYERS
            mix = swa_sink_mixer(x, k_sh, v_sh, b_w_q[j], b_sinks[j], b_w_o[j])
        x = layer_norm(ALPHA * x + mix, ln_g[i, 1], ln_b[i, 1])
        x = layer_norm(ALPHA * x + 0.5 * swiglu(x, ffn2_w_in[i], ffn2_w_out[i]), ln_g[i, 2], ln_b[i, 2])
        if i == N_A_LAYERS - 1:
            k_flat, v_flat = jnp.split(x @ kv_w, 2, axis=-1)
            k_sh = k_flat.reshape(b, S, N_KV_B, HEAD_DIM)
            v_sh = v_flat.reshape(b, S, N_KV_B, HEAD_DIM)
    return x
```

```cpp
#include <hip/hip_runtime.h>
#include <hip/hip_cooperative_groups.h>
#include <cstdio>
#include <cstdint>
#include <cmath>
namespace cg = cooperative_groups;
namespace pg8 {
#define PG8_LAS __attribute__((address_space(3)))
typedef unsigned short bf16_t;
typedef short bf16x8 __attribute__((ext_vector_type(8)));
typedef float f32x4 __attribute__((ext_vector_type(4)));
typedef unsigned u32x4 __attribute__((ext_vector_type(4)));
constexpr int BM = 256, BK = 64, HALF = 128, HTB = HALF * BK * 2  , STAGE_BYTES = 8 * HTB, NXCD = 8, WGM = 8;

__host__ __device__ __forceinline__ int lds_byte(int r, int c) { const int st = (r >> 4) * 2 + (c >> 5), rr = r & 15, cc = c & 31, ob = rr * 64 + cc * 2; return st * 1024 + (ob ^ (((ob >> 9) & 1) << 5)); }
__host__ __device__ __forceinline__ void stage_rc(int b, int& R, int& C) { const int st = b / 1024, sb = b % 1024, swz = sb ^ (((sb >> 9) & 1) << 5); R = (st >> 1) * 16 + swz / 64; C = (st & 1) * 32 + (swz % 64) / 2; }
__host__ __device__ __forceinline__ int perm32(int rho) { const int n = rho >> 4, i = rho & 15; return 8 * (i >> 2) + 4 * n + (i & 3); }

struct Unit { int pm, pn; };
struct Gemm { const bf16_t* A; const bf16_t* Bt; int M, N, K; };

struct StaticOrder {
    int nM, nN, nwg, G, c;
    __host__ __device__ void init(int M, int N, int G_, int c_) { nM = M / BM; nN = N / BM; nwg = nM * nN; G = G_; c = c_; }
    __host__ __device__ bool next(int i, Unit& u) const {
        const long L = (long)i * G + c; if (L >= nwg) return false;
        int wgid = (int)L; { const int q = nwg / NXCD, r = nwg % NXCD, xcd = wgid % NXCD, off = wgid / NXCD; wgid = (xcd < r ? xcd * (q + 1) : r * (q + 1) + (xcd - r) * q) + off; }
        const int nig = WGM * nN, gid = wgid / nig, fm = gid * WGM, gsz = (nM - fm) < WGM ? (nM - fm) : WGM;
        u.pm = fm + ((wgid % nig) % gsz); u.pn = (wgid % nig) / gsz; return true;
    }
    __device__ __forceinline__ void a_ready(const Unit&) const {}
    __device__ __forceinline__ void done(const Unit&) const {}
};


typedef float cvt_f32x2 __attribute__((ext_vector_type(2))); typedef __bf16 cvt_bf16x2 __attribute__((ext_vector_type(2)));
__device__ __forceinline__ unsigned cvt_pk_bf16_safe(float lo, float hi) { const cvt_f32x2 v = {lo, hi}; const cvt_bf16x2 b = __builtin_convertvector(v, cvt_bf16x2); return __builtin_bit_cast(unsigned, b); }
__device__ __forceinline__ unsigned cvt_pk_bf16(float lo, float hi) { unsigned r; asm volatile("v_cvt_pk_bf16_f32 %0, %1, %2" : "=v"(r) : "v"(lo), "v"(hi)); return r; }
#define MFMA_RESULT_GUARD(x) asm volatile("s_nop 15\n\ts_nop 7" :: "v"(x))
typedef unsigned u32x2 __attribute__((ext_vector_type(2)));

struct EpiBf16 {
    static constexpr bool PERM = true, AFTER_DRAIN = false;
    bf16_t* O; int ldc; int split_cols; size_t split_stride;
    __device__ __forceinline__ void operator()(const f32x4 (&acc)[2][2][4][2], const Unit& u, int wr, int wc, int fr, int fq) const {
        const int row0 = u.pm * BM + wr * 64 + fr; int colt = u.pn * BM; bf16_t* base = O;
        if (split_cols) { const int t = colt / split_cols; base += (size_t)t * split_stride; colt -= t * split_cols; }
        const int col0 = colt + wc * 32 + 8 * fq;
        asm volatile("s_nop 15\n\ts_nop 7" :: "v"(acc[1][1][0][0]), "v"(acc[1][1][0][1]), "v"(acc[1][1][1][0]), "v"(acc[1][1][1][1]), "v"(acc[1][1][2][0]), "v"(acc[1][1][2][1]), "v"(acc[1][1][3][0]), "v"(acc[1][1][3][1]));
#pragma unroll
        for (int ai = 0; ai < 2; ++ai)
#pragma unroll
            for (int m = 0; m < 4; ++m) { bf16_t* rowp = base + (size_t)(row0 + ai * HALF + m * 16) * ldc + col0;
#pragma unroll
                for (int bj = 0; bj < 2; ++bj) { const f32x4 v0 = acc[ai][bj][m][0], v1 = acc[ai][bj][m][1];
                    u32x4 w; w.x = cvt_pk_bf16(v0[0], v0[1]); w.y = cvt_pk_bf16(v0[2], v0[3]); w.z = cvt_pk_bf16(v1[0], v1[1]); w.w = cvt_pk_bf16(v1[2], v1[3]);
                    *(u32x4*)(rowp + bj * HALF) = w; } }
    }
};

struct EpiHeads {
    static constexpr bool PERM = true, AFTER_DRAIN = false;
    bf16_t* O; size_t head_stride; float scale0; int scale_heads;
    __device__ __forceinline__ void operator()(const f32x4 (&acc)[2][2][4][2], const Unit& u, int wr, int wc, int fr, int fq) const {
        const int row0 = u.pm * BM + wr * 64 + fr;
#pragma unroll
        for (int bj = 0; bj < 2; ++bj) { const int col = u.pn * BM + bj * HALF + wc * 32 + 8 * fq;
            bf16_t* hp = O + (size_t)(col >> 6) * head_stride + (col & 63); const float sc = ((col >> 6) < scale_heads) ? scale0 : 1.0f;
#pragma unroll
            for (int ai = 0; ai < 2; ++ai)
#pragma unroll
                for (int m = 0; m < 4; ++m) { const f32x4 v0 = acc[ai][bj][m][0] * sc, v1 = acc[ai][bj][m][1] * sc;
                    u32x4 w; w.x = cvt_pk_bf16(v0[0], v0[1]); w.y = cvt_pk_bf16(v0[2], v0[3]); w.z = cvt_pk_bf16(v1[0], v1[1]); w.w = cvt_pk_bf16(v1[2], v1[3]);
                    *(u32x4*)(hp + (size_t)(row0 + ai * HALF + m * 16) * 64) = w; } }
    }
};

struct EpiSwiglu {
    static constexpr bool PERM = false, AFTER_DRAIN = false;
    bf16_t* H; int ldh;
    __device__ __forceinline__ void operator()(const f32x4 (&acc)[2][2][4][2], const Unit& u, int wr, int wc, int fr, int fq) const {
        const int row0 = u.pm * BM + wr * 64 + fr; const int hcol0 = u.pn * 128 + wc * 16 + 4 * fq;
#pragma unroll
        for (int ai = 0; ai < 2; ++ai)
#pragma unroll
            for (int m = 0; m < 4; ++m) { bf16_t* rowp = H + (size_t)(row0 + ai * HALF + m * 16) * ldh + hcol0;
#pragma unroll
                for (int bj = 0; bj < 2; ++bj) { const f32x4 g = acc[ai][bj][m][0], up = acc[ai][bj][m][1]; float h[4];
#pragma unroll
                    for (int i = 0; i < 4; ++i) { const float e = __builtin_amdgcn_exp2f(g[i] * -1.4426950408889634f); h[i] = g[i] * __builtin_amdgcn_rcpf(1.0f + e) * up[i]; }
                    u32x2 w; w.x = cvt_pk_bf16(h[0], h[1]); w.y = cvt_pk_bf16(h[2], h[3]);
                    *(u32x2*)(rowp + bj * 64) = w; } }
    }
};

struct EpiResid {
    static constexpr bool PERM = false, AFTER_DRAIN = false;
    const float* base; float* out; float alpha, scale; int ldc;
    __device__ __forceinline__ void operator()(const f32x4 (&acc)[2][2][4][2], const Unit& u, int wr, int wc, int fr, int fq) const {
        const int row0 = u.pm * BM + wr * 64 + fr; const int col0 = u.pn * BM + wc * 32 + 4 * fq;
#pragma unroll
        for (int ai = 0; ai < 2; ++ai)
#pragma unroll
            for (int m = 0; m < 4; ++m) { const size_t off = (size_t)(row0 + ai * HALF + m * 16) * ldc + col0;
                f32x4 b[2][2];
#pragma unroll
                for (int bj = 0; bj < 2; ++bj)
#pragma unroll
                    for (int n = 0; n < 2; ++n) b[bj][n] = *(const f32x4*)(base + off + bj * HALF + n * 16);
#pragma unroll
                for (int bj = 0; bj < 2; ++bj)
#pragma unroll
                    for (int n = 0; n < 2; ++n) *(f32x4*)(out + off + bj * HALF + n * 16) = b[bj][n] * alpha + acc[ai][bj][m][n] * scale; }
    }
};

template <class Epi, class Sched, bool ALIGN_EPI = false, bool SP2 = false>
__device__ __forceinline__ void gemm_phase(PG8_LAS unsigned char* lds, const Gemm g, const Sched& S, const Epi& E) {
    int tid_ = threadIdx.x; asm volatile("" : "+v"(tid_));
    const int tid = tid_, wid = __builtin_amdgcn_readfirstlane(tid >> 6), lane = tid & 63, wr = wid >> 2, wc = wid & 3, fr = lane & 15, fq = lane >> 4;
    const int K = g.K, nt = K / BK;
    unsigned voffA[2], voffB[2];
#pragma unroll
    for (int i = 0; i < 2; ++i) { int R, C; stage_rc(tid * 16 + i * 8192, R, C); const int Rb = Epi::PERM ? ((R & ~31) + perm32(R & 31)) : R;
        voffA[i] = (unsigned)(R * K + C) * 2u; voffB[i] = (unsigned)(Rb * K + C) * 2u; }
    const size_t kstep = (size_t)(BK * 2);
    const size_t hstep = (size_t)HALF * K * 2;
    const size_t tstep = 2 * hstep;
    const unsigned ldsw = (unsigned)wid * 1024u;
    const int aoff = lds_byte(wr * 64 + fr, fq * 8), boff = lds_byte(wc * 32 + fr, fq * 8);
#define PG8_SA(b, h) (((b) * 2 + (h)) * HTB)
#define PG8_SB(b, h) ((4 + (b) * 2 + (h)) * HTB)
#define PG8_STAGE(bufoff, gbase, voff) do { _Pragma("unroll") for (int _i = 0; _i < 2; ++_i) \
        __builtin_amdgcn_global_load_lds((const unsigned*)((const char*)(gbase) + (voff)[_i]), (PG8_LAS unsigned*)(lds + (bufoff) + ldsw + _i * 8192), 16, 0, 0); } while (0)
#define PG8_LDA(dst, b, h) do { _Pragma("unroll") for (int m = 0; m < 4; ++m) _Pragma("unroll") for (int k = 0; k < 2; ++k) dst[m][k] = *(const PG8_LAS bf16x8*)(lds + PG8_SA(b, h) + aoff + m * 2048 + k * 1024); } while (0)
#define PG8_LDB(dst, b, h) do { _Pragma("unroll") for (int n = 0; n < 2; ++n) _Pragma("unroll") for (int k = 0; k < 2; ++k) dst[n][k] = *(const PG8_LAS bf16x8*)(lds + PG8_SB(b, h) + boff + n * 2048 + k * 1024); } while (0)
#define PG8_MMA(ai, bj, At, Bt) do { __builtin_amdgcn_s_setprio(1); _Pragma("unroll") for (int m = 0; m < 4; ++m) _Pragma("unroll") for (int n = 0; n < 2; ++n) _Pragma("unroll") for (int k = 0; k < 2; ++k) \
        acc[ai][bj][m][n] = __builtin_amdgcn_mfma_f32_16x16x32_bf16(Bt[n][k], At[m][k], acc[ai][bj][m][n], 0, 0, 0); __builtin_amdgcn_s_setprio(0); } while (0)
#define PG8_WAIT_V(n) asm volatile("s_waitcnt vmcnt(" #n ")" ::: "memory")
#define PG8_WAIT_L(n) asm volatile("s_waitcnt lgkmcnt(" #n ")" ::: "memory")
#define PG8_BAR __builtin_amdgcn_s_barrier()
#define PG8_SCHED __builtin_amdgcn_sched_barrier(0)
    Unit cur, nxt; int ui = 0;
    if (!S.next(0, cur)) return;
    f32x4 acc[2][2][4][2];
#pragma unroll
    for (int a = 0; a < 2; ++a)
#pragma unroll
        for (int b = 0; b < 2; ++b)
#pragma unroll
            for (int m = 0; m < 4; ++m)
#pragma unroll
                for (int n = 0; n < 2; ++n) acc[a][b][m][n] = (f32x4){0.f, 0.f, 0.f, 0.f};
    bf16x8 At[4][2], B0[2][2], B1[2][2];
    const char* cA = (const char*)g.A + (size_t)cur.pm * tstep; const char* cB = (const char*)g.Bt + (size_t)cur.pn * tstep;
    S.a_ready(cur);
    if constexpr (SP2) {
        PG8_STAGE(PG8_SB(0, 0), cB, voffB); PG8_STAGE(PG8_SB(0, 1), cB + hstep, voffB); PG8_STAGE(PG8_SA(0, 0), cA, voffA); PG8_STAGE(PG8_SA(0, 1), cA + hstep, voffA);
        if (wr == 1) PG8_BAR;
        PG8_WAIT_V(2); PG8_BAR;
        PG8_STAGE(PG8_SB(1, 0), cB + kstep, voffB); PG8_STAGE(PG8_SA(1, 0), cA + kstep, voffA); PG8_STAGE(PG8_SB(1, 1), cB + hstep + kstep, voffB);
        PG8_WAIT_V(6); PG8_BAR;
    } else {
        PG8_STAGE(PG8_SB(0, 0), cB, voffB); PG8_STAGE(PG8_SA(0, 0), cA, voffA); PG8_STAGE(PG8_SB(0, 1), cB + hstep, voffB); PG8_STAGE(PG8_SA(0, 1), cA + hstep, voffA);
        if (wr == 1) PG8_BAR;
        PG8_WAIT_V(4); PG8_BAR;
        PG8_STAGE(PG8_SB(1, 0), cB + kstep, voffB); PG8_STAGE(PG8_SA(1, 0), cA + kstep, voffA); PG8_STAGE(PG8_SB(1, 1), cB + hstep + kstep, voffB);
        PG8_WAIT_V(6); PG8_BAR;
    }
    for (;;) {
        const bool has_next = S.next(ui + 1, nxt);
        const char* nA = has_next ? (const char*)g.A + (size_t)nxt.pm * tstep : cA; const char* nB = has_next ? (const char*)g.Bt + (size_t)nxt.pn * tstep : cB;
        for (int t = 0; t < nt; t += 2) {
            const bool last = (t == nt - 2);
            const char* a1 = cA + (size_t)(t + 1) * kstep;
            const char* a2 = last ? nA : cA + (size_t)(t + 2) * kstep; const char* b2 = last ? nB : cB + (size_t)(t + 2) * kstep;
            const char* a3 = a2 + kstep; const char* b3 = b2 + kstep;
            if (last && has_next) S.a_ready(nxt);
            if constexpr (SP2) {
            PG8_LDB(B0, 0, 0); PG8_LDB(B1, 0, 1); PG8_SCHED; PG8_LDA(At, 0, 0); PG8_STAGE(PG8_SA(1, 1), a1 + hstep, voffA);
            PG8_WAIT_V(8); PG8_WAIT_L(0); PG8_BAR; PG8_MMA(0, 0, At, B0); PG8_MMA(0, 1, At, B1); PG8_BAR; PG8_SCHED;
            PG8_LDA(At, 0, 1); PG8_STAGE(PG8_SB(0, 0), b2, voffB); PG8_STAGE(PG8_SB(0, 1), b2 + hstep, voffB); PG8_STAGE(PG8_SA(0, 0), a2, voffA);
            PG8_WAIT_V(8); PG8_WAIT_L(0); PG8_BAR; PG8_MMA(1, 0, At, B0); PG8_MMA(1, 1, At, B1); PG8_BAR; PG8_SCHED;
            PG8_LDB(B0, 1, 0); PG8_LDB(B1, 1, 1); PG8_SCHED; PG8_LDA(At, 1, 0); PG8_STAGE(PG8_SA(0, 1), a2 + hstep, voffA);
            PG8_WAIT_V(8); PG8_WAIT_L(0); PG8_BAR; PG8_MMA(0, 0, At, B0); PG8_MMA(0, 1, At, B1); PG8_BAR; PG8_SCHED;
            PG8_LDA(At, 1, 1); PG8_STAGE(PG8_SB(1, 0), b3, voffB); PG8_STAGE(PG8_SB(1, 1), b3 + hstep, voffB); PG8_STAGE(PG8_SA(1, 0), a3, voffA);
            PG8_WAIT_V(8); PG8_WAIT_L(0); PG8_BAR; PG8_MMA(1, 0, At, B0); PG8_MMA(1, 1, At, B1); PG8_BAR; PG8_SCHED;
            } else {
            PG8_LDB(B0, 0, 0); PG8_SCHED; PG8_LDA(At, 0, 0); PG8_STAGE(PG8_SA(1, 1), a1 + hstep, voffA);
            PG8_WAIT_L(8); PG8_BAR; PG8_WAIT_L(0); PG8_MMA(0, 0, At, B0); PG8_BAR; PG8_SCHED;
            PG8_LDB(B1, 0, 1); PG8_STAGE(PG8_SB(0, 0), b2, voffB);
            PG8_BAR; PG8_WAIT_L(0); PG8_MMA(0, 1, At, B1); PG8_BAR;
            PG8_LDA(At, 0, 1); PG8_STAGE(PG8_SA(0, 0), a2, voffA);
            PG8_BAR; PG8_WAIT_L(0); PG8_MMA(1, 0, At, B0); PG8_BAR; PG8_SCHED;
            PG8_STAGE(PG8_SB(0, 1), b2 + hstep, voffB);
            PG8_WAIT_V(6); PG8_BAR; PG8_MMA(1, 1, At, B1); PG8_BAR;
            PG8_LDB(B0, 1, 0); PG8_SCHED; PG8_LDA(At, 1, 0); PG8_STAGE(PG8_SA(0, 1), a2 + hstep, voffA);
            PG8_WAIT_L(8); PG8_BAR; PG8_WAIT_L(0); PG8_MMA(0, 0, At, B0); PG8_BAR; PG8_SCHED;
            PG8_LDB(B1, 1, 1); PG8_STAGE(PG8_SB(1, 0), b3, voffB);
            PG8_BAR; PG8_WAIT_L(0); PG8_MMA(0, 1, At, B1); PG8_BAR;
            PG8_LDA(At, 1, 1); PG8_STAGE(PG8_SA(1, 0), a3, voffA);
            PG8_BAR; PG8_WAIT_L(0); PG8_MMA(1, 0, At, B0); PG8_BAR; PG8_SCHED;
            PG8_STAGE(PG8_SB(1, 1), b3 + hstep, voffB);
            PG8_WAIT_V(6); PG8_BAR; PG8_MMA(1, 1, At, B1); PG8_BAR;
            }
        }
        if constexpr (ALIGN_EPI) { if (wr == 0) PG8_BAR; }
        if constexpr (!Epi::AFTER_DRAIN) { E(acc, cur, wr, wc, fr, fq); S.done(cur); }
        if (!has_next) break;
#pragma unroll
        for (int a = 0; a < 2; ++a)
#pragma unroll
            for (int b = 0; b < 2; ++b)
#pragma unroll
                for (int m = 0; m < 4; ++m)
#pragma unroll
                    for (int n = 0; n < 2; ++n) acc[a][b][m][n] = (f32x4){0.f, 0.f, 0.f, 0.f};
        cur = nxt; cA = nA; cB = nB; ++ui;
        if constexpr (ALIGN_EPI) { if (wr == 1) PG8_BAR; }
    }
    PG8_WAIT_V(0);
    if constexpr (!ALIGN_EPI) { if (wr == 0) PG8_BAR; }
    PG8_BAR;
    if constexpr (Epi::AFTER_DRAIN) { E.fused(acc, cur, wr, wc, fr, fq, lds, wid, lane); S.done(cur); }
#undef PG8_SA
#undef PG8_SB
#undef PG8_STAGE
#undef PG8_LDA
#undef PG8_LDB
#undef PG8_MMA
#undef PG8_WAIT_V
#undef PG8_WAIT_L
#undef PG8_BAR
#undef PG8_SCHED
}
}

constexpr int NB = 8, SEQ = 4096, DM = 1024, DFF = 2816, NH = 16, HD = 64, NKV = 4;
constexpr int M = NB * SEQ;
constexpr float LN_EPS = 1e-5f;
constexpr float ALPHA = 1.41421356237309515f;
constexpr int NWAVES = 8;
constexpr int LDS_BYTES = 155648;

#define GAS __attribute__((address_space(1)))
#define LAS __attribute__((address_space(3)))
typedef unsigned short bf16;
typedef unsigned v4u __attribute__((ext_vector_type(4)));
typedef unsigned v2u __attribute__((ext_vector_type(2)));
typedef float f32x4 __attribute__((ext_vector_type(4)));
typedef short bf16x8 __attribute__((ext_vector_type(8)));
typedef short s16x4 __attribute__((ext_vector_type(4)));
typedef float f32x16 __attribute__((ext_vector_type(16)));
#define LDS_WAIT() asm volatile("s_waitcnt lgkmcnt(0)" ::: "memory")

constexpr size_t MiB = 1u << 20;
constexpr size_t WS_CTL = 0;
constexpr size_t WS_WIN = 1 * MiB;
constexpr size_t WIN_BYTES = (size_t)2 * DFF * DM * 2;
constexpr size_t WS_WOUT = WS_WIN + 4 * WIN_BYTES;
constexpr size_t WOUT_BYTES = (size_t)DM * DFF * 2;
constexpr size_t WS_WQKV = WS_WOUT + 4 * WOUT_BYTES;
constexpr size_t WS_WAO = WS_WQKV + 6 * MiB;
constexpr size_t WS_WKV = WS_WAO + 2 * MiB;
constexpr size_t WS_WBQ = WS_WKV + 1 * MiB;
constexpr size_t WS_WBO = WS_WBQ + 2 * MiB;
constexpr size_t WS_KVSH = 80 * MiB;
constexpr size_t WS_XN = 112 * MiB;
constexpr size_t WS_BIG = 176 * MiB;
constexpr size_t WS_Q = WS_BIG, WS_K = WS_BIG + 64 * MiB, WS_V = WS_BIG + 128 * MiB, WS_OP4 = WS_BIG + 192 * MiB, WS_LSE4 = WS_BIG + 256 * MiB, WS_LSE16 = WS_BIG + 258 * MiB;
constexpr size_t WS_XL = WS_BIG + 260 * MiB;
constexpr size_t WS_END = WS_XL + 32 * MiB;
static_assert(WS_WBO + 2 * MiB <= WS_KVSH, "weight copies fit below KVSH");

__device__ __forceinline__ unsigned f2bf(float f) { unsigned u = __builtin_bit_cast(unsigned, f); return (u + 0x7fffu + ((u >> 16) & 1u)) >> 16; }
__device__ __forceinline__ unsigned pk2(float lo, float hi) { return f2bf(lo) | (f2bf(hi) << 16); }
__device__ __forceinline__ float bf2f(unsigned short b) { return __builtin_bit_cast(float, (unsigned)b << 16); }

template <bool SWI>
__device__ __forceinline__ void transpose_item(const float* W, int K, int N, bf16* WT, LAS float* scr, int item, int nblk, int lane) {
    const int kb = item / nblk, nb = item % nblk, k0 = 64 * kb, n0 = 32 * nb;
    const int j = lane & 31;
    const int scol = SWI ? (nb * 16 + (j & 15) + ((j & 16) ? DFF : 0)) : (n0 + j);
#pragma unroll
    for (int i = 0; i < 32; ++i) { const int kk = 2 * i + (lane >> 5); scr[kk * 33 + j] = W[(size_t)(k0 + kk) * N + scol]; }
    LDS_WAIT();
    const int c = lane & 7;
#pragma unroll
    for (int jj = 0; jj < 4; ++jj) { const int n = (lane >> 3) + 8 * jj; const LAS float* s = scr + (8 * c) * 33 + n;
        v4u o; o.x = pk2(s[0 * 33], s[1 * 33]); o.y = pk2(s[2 * 33], s[3 * 33]); o.z = pk2(s[4 * 33], s[5 * 33]); o.w = pk2(s[6 * 33], s[7 * 33]);
        *(v4u*)(WT + (size_t)(n0 + n) * K + k0 + 8 * c) = o; }
    LDS_WAIT();
}
template <bool SWI>
__device__ __forceinline__ void transpose_matrix(const float* W, int K, int N, bf16* WT, LAS float* scr, int gw, int ngw, int lane) {
    const int nblk = N / 32, nitems = (K / 64) * nblk;
    for (int it = gw; it < nitems; it += ngw) transpose_item<SWI>(W, K, N, WT, scr, it, nblk, lane);
}

constexpr int T_TOTAL = 4 * 2816 + 4 * 1408 + 1536 + 512 + 256 + 512 + 512;
struct TDesc { const float* W; bf16* WT; int K, N, k0, nb; bool swi; };
struct TIn { const float *w1in, *w1out, *w2in, *w2out, *qkv, *ao, *kv, *bq, *bo; };
__device__ __forceinline__ TDesc t_decode(const TIn in, unsigned char* ws, int it) {
    TDesc d; int r, nblk;
    const float *w1in = in.w1in, *w1out = in.w1out, *w2in = in.w2in, *w2out = in.w2out, *qkv = in.qkv, *ao = in.ao, *kv = in.kv, *bq = in.bq, *bo = in.bo;
    if (it < 11264) { const int m = it / 2816; r = it % 2816; d.K = DM; d.N = 2 * DFF; d.swi = true; nblk = 176;
        d.W = ((m >> 1) ? w2in : w1in) + (size_t)(m & 1) * DM * 2 * DFF; d.WT = (bf16*)(ws + WS_WIN + (size_t)m * WIN_BYTES); }
    else if (it < 16896) { const int q = it - 11264, m = q / 1408; r = q % 1408; d.K = DFF; d.N = DM; d.swi = false; nblk = 32;
        d.W = ((m >> 1) ? w2out : w1out) + (size_t)(m & 1) * DFF * DM; d.WT = (bf16*)(ws + WS_WOUT + (size_t)m * WOUT_BYTES); }
    else { const int q = it - 16896; d.K = DM; d.swi = false;
        if (q < 1536) { r = q; d.N = 3 * DM; nblk = 96; d.W = qkv; d.WT = (bf16*)(ws + WS_WQKV); }
        else if (q < 2048) { r = q - 1536; d.N = DM; nblk = 32; d.W = ao; d.WT = (bf16*)(ws + WS_WAO); }
        else if (q < 2304) { r = q - 2048; d.N = 512; nblk = 16; d.W = kv; d.WT = (bf16*)(ws + WS_WKV); }
        else if (q < 2816) { r = q - 2304; d.N = DM; nblk = 32; d.W = bq; d.WT = (bf16*)(ws + WS_WBQ); }
        else { r = q - 2816; d.N = DM; nblk = 32; d.W = bo; d.WT = (bf16*)(ws + WS_WBO); } }
    d.k0 = (r / nblk) * 64; d.nb = r % nblk; return d;
}
__device__ __forceinline__ void t_load(const TDesc& d, f32x4 (&v)[8], int lane) {
    const int j4 = 4 * (lane & 7);
    const int scol = d.swi ? (d.nb * 16 + (j4 & 15) + ((j4 & 16) ? DFF : 0)) : (d.nb * 32 + j4);
#pragma unroll
    for (int i = 0; i < 8; ++i) v[i] = __builtin_nontemporal_load((const f32x4*)(d.W + (size_t)(d.k0 + 8 * i + (lane >> 3)) * d.N + scol));
}
__device__ __forceinline__ void t_store(const TDesc& d, const f32x4 (&v)[8], LAS float* scr, int lane) {
    const int j4 = 4 * (lane & 7);
#pragma unroll
    for (int i = 0; i < 8; ++i) { LAS float* p = scr + (8 * i + (lane >> 3)) * 33 + j4; p[0] = v[i].x; p[1] = v[i].y; p[2] = v[i].z; p[3] = v[i].w; }
    LDS_WAIT();
    const int c = lane & 7;
#pragma unroll
    for (int jj = 0; jj < 4; ++jj) { const int n = (lane >> 3) + 8 * jj; const LAS float* s = scr + (8 * c) * 33 + n;
        v4u o; o.x = pk2(s[0 * 33], s[1 * 33]); o.y = pk2(s[2 * 33], s[3 * 33]); o.z = pk2(s[4 * 33], s[5 * 33]); o.w = pk2(s[6 * 33], s[7 * 33]);
        *(v4u*)(d.WT + (size_t)(d.nb * 32 + n) * d.K + d.k0 + 8 * c) = o; }
    LDS_WAIT();
}

__device__ __forceinline__ float wave_sum(float v) {
#pragma unroll
    for (int o = 1; o < 64; o <<= 1) v += __shfl_xor(v, o);
    return v;
}
__device__ __forceinline__ float res_dec(unsigned hi16, unsigned word, int sh) { const int d2 = (int)((word >> sh) << 30) >> 30; return __builtin_bit_cast(float, (hi16 << 16) + ((unsigned)d2 << 14) + 8192u); }
__device__ __forceinline__ unsigned res_enc_lo(float x, unsigned hi16) {
    int d = (int)(__builtin_bit_cast(unsigned, x) - (hi16 << 16)); d >>= 14; d = d < -2 ? -2 : (d > 1 ? 1 : d); return (unsigned)d & 0x3u; }
template <bool IN_F32, bool OUT_F32>
__device__ __forceinline__ void ln_rows4(const float* xin, const bf16* yrow, float scale, float* oout, bf16* xn, unsigned* xl, const float* g, const float* b, int lane) {
    f32x4 v[4][4]; v2u yv[4][4];
    if (IN_F32) {
#pragma unroll
        for (int r = 0; r < 4; ++r)
#pragma unroll
            for (int j = 0; j < 4; ++j) v[r][j] = __builtin_nontemporal_load((const f32x4*)(xin + (size_t)r * DM) + lane + 64 * j);
    } else {
        v2u hv[4][4]; unsigned lv[4];
#pragma unroll
        for (int r = 0; r < 4; ++r) { lv[r] = __builtin_nontemporal_load((const unsigned*)(xl + (size_t)r * 64) + lane);
#pragma unroll
            for (int j = 0; j < 4; ++j) hv[r][j] = __builtin_nontemporal_load((const v2u*)(xn + (size_t)r * DM) + lane + 64 * j); }
#pragma unroll
        for (int r = 0; r < 4; ++r)
#pragma unroll
            for (int j = 0; j < 4; ++j) { const unsigned h0 = hv[r][j].x, h1 = hv[r][j].y; const unsigned l = lv[r]; const int sh = 8 * j;
                v[r][j] = (f32x4){res_dec(h0 & 0xffffu, l, sh), res_dec(h0 >> 16, l, sh + 2), res_dec(h1 & 0xffffu, l, sh + 4), res_dec(h1 >> 16, l, sh + 6)}; }
    }
#pragma unroll
    for (int r = 0; r < 4; ++r)
#pragma unroll
        for (int j = 0; j < 4; ++j) yv[r][j] = __builtin_nontemporal_load((const v2u*)(yrow + (size_t)r * DM) + lane + 64 * j);
    float mean[4], rstd[4];
#pragma unroll
    for (int r = 0; r < 4; ++r) { float s = 0.f;
#pragma unroll
        for (int j = 0; j < 4; ++j) { const f32x4 y = {__builtin_bit_cast(float, yv[r][j].x << 16), __builtin_bit_cast(float, yv[r][j].x & 0xffff0000u), __builtin_bit_cast(float, yv[r][j].y << 16), __builtin_bit_cast(float, yv[r][j].y & 0xffff0000u)};
            v[r][j] = v[r][j] * ALPHA + y * scale; s += (v[r][j].x + v[r][j].y) + (v[r][j].z + v[r][j].w); }
        mean[r] = wave_sum(s) * (1.f / DM); }
#pragma unroll
    for (int r = 0; r < 4; ++r) { float s2 = 0.f;
#pragma unroll
        for (int j = 0; j < 4; ++j) { v[r][j] = v[r][j] - mean[r]; s2 += (v[r][j].x * v[r][j].x + v[r][j].y * v[r][j].y) + (v[r][j].z * v[r][j].z + v[r][j].w * v[r][j].w); }
        rstd[r] = 1.f / sqrtf(wave_sum(s2) * (1.f / DM) + LN_EPS); }
    unsigned xw[4];
#pragma unroll
    for (int r = 0; r < 4; ++r) xw[r] = 0u;
#pragma unroll
    for (int j = 0; j < 4; ++j) { const f32x4 gg = ((const f32x4*)g)[lane + 64 * j], bb = ((const f32x4*)b)[lane + 64 * j];
#pragma unroll
        for (int r = 0; r < 4; ++r) { const f32x4 y = v[r][j] * rstd[r] * gg + bb;
            if (OUT_F32) __builtin_nontemporal_store(y, (f32x4*)(oout + (size_t)r * DM) + lane + 64 * j);
            else { v2u w; w.x = pk2(y.x, y.y); w.y = pk2(y.z, y.w); ((v2u*)(xn + (size_t)r * DM))[lane + 64 * j] = w;
                xw[r] |= (res_enc_lo(y.x, w.x & 0xffffu) | (res_enc_lo(y.y, w.x >> 16) << 2) | (res_enc_lo(y.z, w.y & 0xffffu) << 4) | (res_enc_lo(y.w, w.y >> 16) << 6)) << (8 * j); } } }
    if (!OUT_F32) {
#pragma unroll
        for (int r = 0; r < 4; ++r) __builtin_nontemporal_store(xw[r], (unsigned*)(xl + (size_t)r * 64) + lane);
    }
}

namespace att {
constexpr int VP = 144;
constexpr float SC2 = 0.125f * 1.4426950408889634f;
__device__ __forceinline__ int crow(int r, int hi) { return (r & 3) + 8 * (r >> 2) + 4 * hi; }
__device__ __forceinline__ unsigned cvtpk(float lo, float hi) { return pg8::cvt_pk_bf16(lo, hi); }
typedef short v4i16_t __attribute__((ext_vector_type(4)));
__device__ __forceinline__ s16x4 vtr(LAS const unsigned char* p) { return __builtin_bit_cast(s16x4, __builtin_amdgcn_ds_read_tr16_b64_v4i16((LAS v4i16_t*)p)); }

constexpr int TROWS = 384, KT_OFF = 0, VT_OFF = TROWS * VP, WV_OFF = 2 * TROWS * VP, WV_BYTES = 32 * VP + 512;
constexpr int WG_LDS_END = WV_OFF + 8 * WV_BYTES;
template <int MODE>
__device__ __forceinline__ void decode(int wt, int& b, int& h, int& d, int& r, int& Q0, int& pat) {
    if (MODE == 0) { pat = wt >> 11; int tt = wt & 2047; d = pat ? 4 : 16; const int nblk = pat ? 4 : 1;
        const int blk = tt % nblk; tt /= nblk; r = tt % d; tt /= d; h = tt & 15; b = tt >> 4; Q0 = blk * 256; }
    else { pat = 0; d = 1; r = 0; Q0 = (wt & 15) * 256; h = (wt >> 4) & 15; b = wt >> 8; }
}
template <int MODE>
__device__ __forceinline__ void wg_attention(LAS unsigned char* lds, int tid, int G, int bx,
        const bf16* QH, const bf16* KH, const bf16* VH,
        bf16* OB, bf16* OP4, bf16* OP16, float* LSE4, float* LSE16, const float* sinks) {
    const int lane = tid & 63, wave = __builtin_amdgcn_readfirstlane(tid >> 6), r32 = lane & 31, hi = lane >> 5;
    const int ntasks = (MODE == 0) ? 4096 : 2048;
    const float NEG = -INFINITY;
    LAS unsigned char* wv = lds + WV_OFF + wave * WV_BYTES;
    LAS float* wsf = (LAS float*)(wv + 32 * VP);
    v4u kreg[6], vreg[6], qreg[4];
    int b, h, d, r, Q0, pat;
#define ATT_PREFETCH(newt_) do { \
        const int kvh_ = (MODE == 2) ? (h >> 2) : h; \
        const bf16* Kp_ = KH + ((size_t)kvh_ * M + (size_t)b * SEQ) * HD; const bf16* Vp_ = VH + ((size_t)kvh_ * M + (size_t)b * SEQ) * HD; \
        const bf16* Qp_ = QH + ((size_t)h * M + (size_t)b * SEQ) * HD; \
        const unsigned toff_ = (unsigned)(((tid >> 3) * d * HD + 8 * (tid & 7)) * 2), loff_ = (unsigned)(((lane >> 3) * d * HD + 8 * (lane & 7)) * 2); \
        if (newt_) { _Pragma("unroll") for (int i = 0; i < 6; ++i) { const int row0_ = Q0 - 128 + 64 * i; \
            if (Q0 == 0 && i < 2) { kreg[i] = (v4u){0u, 0u, 0u, 0u}; vreg[i] = (v4u){0u, 0u, 0u, 0u}; }     \
            else { kreg[i] = __builtin_nontemporal_load((const v4u*)((const char*)(Kp_ + (r + (long)d * row0_) * HD) + toff_)); vreg[i] = __builtin_nontemporal_load((const v4u*)((const char*)(Vp_ + (r + (long)d * row0_) * HD) + toff_)); } } } \
        _Pragma("unroll") for (int i = 0; i < 4; ++i) qreg[i] = __builtin_nontemporal_load((const v4u*)((const char*)(Qp_ + (r + (long)d * (Q0 + 32 * wave + 8 * i)) * HD) + loff_)); } while (0)
#define ATT_TASK(it_, valid_, newt_) do { if (MODE == 2) { const int T_ = bx + G * ((it_) >> 2); valid_ = T_ < 512; newt_ = ((it_) & 3) == 0; \
            if (valid_) { pat = 0; d = 1; r = 0; Q0 = (T_ & 15) * 256; h = ((T_ >> 4) & 3) * 4 + ((it_) & 3); b = T_ >> 6; } } \
        else { const int wt_ = bx + (it_) * G; valid_ = wt_ < ntasks; newt_ = true; if (valid_) decode<MODE>(wt_, b, h, d, r, Q0, pat); } } while (0)
    int it = 0; bool valid, newt;
    ATT_TASK(0, valid, newt);
    if (valid) ATT_PREFETCH(newt);
    while (valid) {
        if (newt) {
#pragma unroll
            for (int i = 0; i < 6; ++i) { *(LAS v4u*)(lds + KT_OFF + ((tid >> 3) + 64 * i) * VP + 16 * (tid & 7)) = kreg[i]; *(LAS v4u*)(lds + VT_OFF + ((tid >> 3) + 64 * i) * VP + 16 * (tid & 7)) = vreg[i]; }
        }
#pragma unroll
        for (int i = 0; i < 4; ++i) *(LAS v4u*)(wv + ((lane >> 3) + 8 * i) * VP + 16 * (lane & 7)) = qreg[i];
        const int cb = b, ch = h, cd = d, cr = r, cQ0 = Q0, cpat = pat;
        const int q0 = cQ0 + 32 * wave;
        const float slope2 = exp2f(-0.5f * (float)(ch + 1)) * (float)cd * 1.4426950408889634f;
        const float sink2 = (MODE == 2) ? sinks[ch] * 1.4426950408889634f : 0.f;
        const int maxdist = (MODE == 2) ? 127 : 128;
        const size_t ro = (size_t)cb * SEQ * DM + ch * HD;
        const unsigned eoff = (unsigned)(((lane >> 3) * cd * DM + 8 * (lane & 7)) * 2);
        const long tq = cr + (long)cd * (q0 + r32);
        __syncthreads();
        bool nvalid, nnewt; ATT_TASK(it + 1, nvalid, nnewt);
        if (nvalid) ATT_PREFETCH(nnewt);
        __builtin_amdgcn_sched_barrier(0);
        bf16x8 qr[4];
#pragma unroll
        for (int d0 = 0; d0 < 4; ++d0) qr[d0] = *(LAS const bf16x8*)(wv + r32 * VP + hi * 16 + d0 * 32);
        int dbase = r32 + 128 - 4 * hi; asm volatile("" : "+v"(dbase));
        const float bias0 = -slope2 * (float)dbase;
        f32x16 base;
#pragma unroll
        for (int g = 0; g < 16; ++g) base[g] = fmaf(slope2, (float)((g & 3) + 8 * (g >> 2)), bias0);
        f32x16 S[5];
#pragma unroll
        for (int c = 0; c < 5; ++c) {
            LAS const unsigned char* kb = lds + KT_OFF + (32 * (wave + c) + r32) * VP + hi * 16;
            bf16x8 kf[4];
#pragma unroll
            for (int d0 = 0; d0 < 4; ++d0) kf[d0] = *(LAS const bf16x8*)(kb + d0 * 32);
            const float tc = ((q0 - 128 + 32 * c) >= 0) ? slope2 * (float)(32 * c) : NEG;
            f32x16 a;
#pragma unroll
            for (int g = 0; g < 16; ++g) a[g] = base[g] + tc;
#pragma unroll
            for (int d0 = 0; d0 < 4; ++d0) a = __builtin_amdgcn_mfma_f32_32x32x16_bf16(kf[d0], qr[d0], a, 0, 0, 0);
            S[c] = a;
        }
        __builtin_amdgcn_sched_barrier(0);
        v4u p4[4], p16[4]; float l4 = 0.f, l16 = 0.f;
        if (MODE == 1) {
            { const int s_ = (int)tq; l4 = LSE4[(((size_t)cb * NH + ch) * 4 + (s_ & 3)) * (SEQ / 4) + (s_ >> 2)]; l16 = LSE16[(((size_t)cb * NH + ch) * 16 + (s_ & 15)) * (SEQ / 16) + (s_ >> 4)]; }
#pragma unroll
            for (int i = 0; i < 4; ++i) { const size_t tokb = (ro + (size_t)(cr + (long)cd * (q0 + 8 * i)) * DM) * 2;
                p4[i] = __builtin_nontemporal_load((const v4u*)((const char*)OP4 + tokb + eoff)); p16[i] = __builtin_nontemporal_load((const v4u*)((const char*)OP16 + tokb + eoff)); }
        }
#pragma unroll
        for (int g = 0; g < 16; ++g) { const int ce = (g & 3) + 8 * (g >> 2);
            S[0][g] = (dbase - ce <= maxdist) ? S[0][g] : NEG;
            S[4][g] = (dbase - (128 + ce) >= 0) ? S[4][g] : NEG; }
        float m = NEG;
#pragma unroll
        for (int c = 0; c < 5; ++c) {
#pragma unroll
            for (int g = 0; g < 16; g += 2) m = fmaxf(fmaxf(m, S[c][g]), S[c][g + 1]);
        }
        __builtin_amdgcn_sched_barrier(0);
        m = fmaxf(m, __shfl_xor(m, 32));
        if (MODE == 2) m = fmaxf(m, sink2);
        typedef float f32x2 __attribute__((ext_vector_type(2)));
        const f32x2 mm = {m, m}; f32x2 ls = {0.f, 0.f};
        v4u pa[5][2];
#pragma unroll
        for (int c = 0; c < 5; ++c) {
#pragma unroll
            for (int s = 0; s < 2; ++s) { unsigned w[4];
#pragma unroll
                for (int k = 0; k < 4; ++k) { f32x2 v = {S[c][8 * s + 2 * k], S[c][8 * s + 2 * k + 1]}; v = v - mm;
                    f32x2 p; p.x = __builtin_amdgcn_exp2f(v.x); p.y = __builtin_amdgcn_exp2f(v.y); ls = ls + p; w[k] = cvtpk(p.x, p.y); }
                pa[c][s].x = w[0]; pa[c][s].y = w[1]; pa[c][s].z = w[2]; pa[c][s].w = w[3]; }
            __builtin_amdgcn_sched_barrier(0);
        }
        float l = ls.x + ls.y;
        l += __shfl_xor(l, 32);
        if (MODE == 2) l += __builtin_amdgcn_exp2f(sink2 - m);
        f32x16 o[2];
#pragma unroll
        for (int g = 0; g < 16; ++g) { o[0][g] = 0.f; o[1][g] = 0.f; }
        LAS const unsigned char* vrd = lds + VT_OFF + (32 * wave + 4 * hi + ((lane & 15) >> 2)) * VP + (16 * ((lane >> 4) & 1) + 4 * (lane & 3)) * 2;
#pragma unroll
        for (int c = 0; c < 5; ++c)
#pragma unroll
            for (int s = 0; s < 2; ++s)
#pragma unroll
                for (int d0 = 0; d0 < 2; ++d0) {
                    const s16x4 lo = vtr(vrd + (32 * c + 16 * s) * VP + 64 * d0), hh = vtr(vrd + (32 * c + 16 * s + 8) * VP + 64 * d0);
                    const bf16x8 vf = (bf16x8){lo[0], lo[1], lo[2], lo[3], hh[0], hh[1], hh[2], hh[3]};
                    o[d0] = __builtin_amdgcn_mfma_f32_32x32x16_bf16(__builtin_bit_cast(bf16x8, pa[c][s]), vf, o[d0], 0, 0, 0);
                }
        const float lse2 = m + __builtin_amdgcn_logf(l);
        if (MODE == 1) {
            const float mx = fmaxf(lse2, fmaxf(l4, l16));
            const float e1 = __builtin_amdgcn_exp2f(lse2 - mx), e4 = __builtin_amdgcn_exp2f(l4 - mx), e16 = __builtin_amdgcn_exp2f(l16 - mx);
            const float it = 1.0f / (e1 + e4 + e16);
            if (hi == 0) { wsf[r32] = e1 * it / l; wsf[32 + r32] = e4 * it; wsf[64 + r32] = e16 * it; }
        } else {
            if (hi == 0) { wsf[r32] = 1.0f / l; if (MODE == 0) (cpat ? LSE4 : LSE16)[(((size_t)cb * NH + ch) * cd + cr) * (SEQ / cd) + (q0 + r32)] = lse2; }
        }
        LAS unsigned short* stg = (LAS unsigned short*)wv;
        MFMA_RESULT_GUARD(o[0]); MFMA_RESULT_GUARD(o[1]);
#pragma unroll
        for (int g = 0; g < 16; ++g) { const int q = (g & 3) + 8 * (g >> 2) + 4 * hi; const unsigned w = cvtpk(o[0][g], o[1][g]);
            stg[q * (VP / 2) + r32] = (unsigned short)(w & 0xffffu); stg[q * (VP / 2) + 32 + r32] = (unsigned short)(w >> 16); }
        LDS_WAIT();
        bf16* Odst = (MODE == 0) ? (cpat ? OP4 : OP16) : OB;
#pragma unroll
        for (int i = 0; i < 4; ++i) {
            const int row = (lane >> 3) + 8 * i;
            const size_t tokb = (ro + (size_t)(cr + (long)cd * (q0 + 8 * i)) * DM) * 2;
            const float f = wsf[row];
            const v4u ov = *(LAS const v4u*)(wv + row * VP + 16 * (lane & 7));
            float v[8];
#pragma unroll
            for (int j = 0; j < 4; ++j) { v[2 * j] = __builtin_bit_cast(float, ov[j] << 16) * f; v[2 * j + 1] = __builtin_bit_cast(float, ov[j] & 0xffff0000u) * f; }
            if (MODE == 1) { const float w4 = wsf[32 + row], w16 = wsf[64 + row];
#pragma unroll
                for (int j = 0; j < 4; ++j) { v[2 * j] += w4 * __builtin_bit_cast(float, p4[i][j] << 16) + w16 * __builtin_bit_cast(float, p16[i][j] << 16);
                                               v[2 * j + 1] += w4 * __builtin_bit_cast(float, p4[i][j] & 0xffff0000u) + w16 * __builtin_bit_cast(float, p16[i][j] & 0xffff0000u); } }
            v4u w; w.x = cvtpk(v[0], v[1]); w.y = cvtpk(v[2], v[3]); w.z = cvtpk(v[4], v[5]); w.w = cvtpk(v[6], v[7]);
            *(v4u*)((char*)Odst + tokb + eoff) = w;
        }
        __syncthreads();
        valid = nvalid; newt = nnewt; ++it;
    }
#undef ATT_PREFETCH
#undef ATT_TASK
}
}

typedef GAS unsigned gu32;
#define XB_TMO      128
#define XB_XCNT(j)  (256  + 64 * (j))
#define XB_XSUB(j)  (1280 + 64 * (j))
#define XB_XGEN(j)  (2304 + 64 * (j))
#define XB_TOP      3328
#define XB_TOPGEN   3392
#define XCD_BAR_WORDS 3456
#define XB_SPIN_CAP (1u << 18)

__device__ __forceinline__ unsigned xb_ld(unsigned* p)              { return __hip_atomic_load(p, __ATOMIC_RELAXED, __HIP_MEMORY_SCOPE_AGENT); }
__device__ __forceinline__ unsigned xb_add(unsigned* p, unsigned v) { return __hip_atomic_fetch_add(p, v, __ATOMIC_RELAXED, __HIP_MEMORY_SCOPE_AGENT); }
__device__ __forceinline__ unsigned xb_xcc_id() { return (unsigned)__builtin_amdgcn_s_getreg((3 << 11) | 20) & 0xFu; }
#define XB_SPIN(cond, bar) do { unsigned _sp = 0; while (cond) { __builtin_amdgcn_s_sleep(1); \
    if ((++_sp & 255u) == 0u) { if (xb_ld(&(bar)[XB_TMO])) break; if (_sp > XB_SPIN_CAP) { atomicAdd(&(bar)[XB_TMO], 1u); break; } } } } while (0)

struct XcdBarrier {
    unsigned* bar; unsigned x;
    volatile LAS unsigned* st;
};

__device__ __forceinline__ XcdBarrier xcd_barrier_post(unsigned* bar, volatile LAS unsigned* st) {
    XcdBarrier b; b.bar = bar; b.x = xb_xcc_id(); b.st = st;
    if (threadIdx.x == 0) (void)xb_add(&bar[XB_XCNT(b.x)], 1u);
    return b;
}
__device__ __forceinline__ void xcd_barrier_complete(unsigned* bar, unsigned x, unsigned& nloc, unsigned& nx) {
    const unsigned G = gridDim.x * gridDim.y * gridDim.z;
    unsigned sum, cnt, mine, sp = 0u;
    for (;;) {
        sum = 0u; cnt = 0u; mine = 0u;
#pragma unroll
        for (unsigned j = 0; j < 16; ++j) { const unsigned c = xb_ld(&bar[XB_XCNT(j)]); sum += c; cnt += (c > 0u) ? 1u : 0u; mine = (j == x) ? c : mine; }
        if (sum == G) break;
        __builtin_amdgcn_s_sleep(1);
        if ((++sp & 255u) == 0u) { if (xb_ld(&bar[XB_TMO])) break; if (sp > XB_SPIN_CAP) { atomicAdd(&bar[XB_TMO], 1u); break; } }
    }
    nloc = mine > 0u ? mine : 1u; nx = cnt > 0u ? cnt : 1u;
}

__device__ __forceinline__ void xcd_barrier(const XcdBarrier& b) {
    asm volatile("s_waitcnt vmcnt(0)" ::: "memory");
    __syncthreads();
    if (threadIdx.x == 0) {
        unsigned* bar = b.bar;
        __builtin_amdgcn_s_waitcnt(0);
        unsigned nloc = b.st[0], nx = b.st[1];
        if (nloc == 0u) { xcd_barrier_complete(bar, b.x, nloc, nx); b.st[0] = nloc; b.st[1] = nx; }
        const unsigned old = xb_add(&bar[XB_XSUB(b.x)], 1u);
        const unsigned gen = old / nloc;
        if (old + 1u == (gen + 1u) * nloc) {
            __builtin_amdgcn_fence(__ATOMIC_RELEASE, "agent");
            asm volatile("s_waitcnt vmcnt(0)" ::: "memory");
            const unsigned og = xb_add(&bar[XB_TOP], 1u);
            const unsigned tg = og / nx;
            if (og + 1u == (tg + 1u) * nx) xb_add(&bar[XB_TOPGEN], 1u);
            else XB_SPIN(xb_ld(&bar[XB_TOPGEN]) == tg, bar);
            __builtin_amdgcn_fence(__ATOMIC_ACQUIRE, "agent");
            xb_add(&bar[XB_XGEN(b.x)], 1u);
            asm volatile("s_waitcnt vmcnt(0)" ::: "memory");
        } else {
            XB_SPIN(xb_ld(&bar[XB_XGEN(b.x)]) == gen, bar);
            __builtin_amdgcn_fence(__ATOMIC_ACQUIRE, "agent");
            asm volatile("s_waitcnt vmcnt(0)" ::: "memory");
        }
    }
    __syncthreads();
}

struct Args { const float* in[13]; float* out; unsigned char* ws; };
struct Ctx { LAS unsigned char* lds; int tid, lane, wave, G, bx, gw, ngw; unsigned char* ws; float* X32; const float* in[13]; };

#define GRID_SYNC() xcd_barrier(bar)

template <int OP, int V, bool FIRST>
__device__ __forceinline__ void phase(const Ctx& C) {
    unsigned char* ws = C.ws; LAS unsigned char* lds = C.lds;
    int lane_ = C.lane; asm volatile("" : "+v"(lane_));
    const int lane = lane_, wave = C.wave, G = C.G, bx = C.bx, gw = C.gw, ngw = C.ngw;
    float* X32 = C.X32;
    bf16* XN = (bf16*)(ws + WS_XN);
    bf16* HB = (bf16*)(ws + WS_BIG);
    bf16* QB = (bf16*)(ws + WS_Q); bf16* KB = (bf16*)(ws + WS_K); bf16* VB = (bf16*)(ws + WS_V);
    bf16* OP4 = (bf16*)(ws + WS_OP4); bf16* OP16 = (bf16*)C.X32;
    float* LSE4 = (float*)(ws + WS_LSE4); float* LSE16 = (float*)(ws + WS_LSE16);
    bf16* KSH = (bf16*)(ws + WS_KVSH); bf16* VSH = KSH + (size_t)M * 256;
    bf16* OB = (bf16*)C.X32;
    if constexpr (OP == 0) {
        LAS float* scr = (LAS float*)(lds + wave * 16384);
        {
            const TIn tin{C.in[1], C.in[2], C.in[3], C.in[4], C.in[7], C.in[8], C.in[9], C.in[10], C.in[12]};
            f32x4 va[8], vb[8]; TDesc da, db; int it = gw;
            if (it < T_TOTAL) { da = t_decode(tin, ws, it); t_load(da, va, lane); }
            while (it < T_TOTAL) {
                const int it2 = it + ngw;
                if (it2 < T_TOTAL) { db = t_decode(tin, ws, it2); t_load(db, vb, lane); }
                t_store(da, va, scr, lane);
                if (it2 >= T_TOTAL) break;
                const int it3 = it2 + ngw;
                if (it3 < T_TOTAL) { da = t_decode(tin, ws, it3); t_load(da, va, lane); }
                t_store(db, vb, scr, lane);
                it = it3;
            }
        }
        const float* x_in = C.in[0];
        const size_t nchunk = (size_t)M * DM / 8, gt = (size_t)bx * (NWAVES * 64) + C.tid, ngt = (size_t)G * NWAVES * 64;
        static_assert(((size_t)M * DM / 8) % ((size_t)256 * NWAVES * 64 * 4) == 0, "x conversion: four chunks per thread per trip on a 256-workgroup grid");
        for (size_t c = gt; c < nchunk; c += 4 * ngt) {
            f32x4 a[4], b[4];
#pragma unroll
            for (int u = 0; u < 4; ++u) { const size_t cc = c + u * ngt; if (cc < nchunk) { a[u] = __builtin_nontemporal_load((const f32x4*)x_in + 2 * cc); b[u] = __builtin_nontemporal_load((const f32x4*)x_in + 2 * cc + 1); } }
#pragma unroll
            for (int u = 0; u < 4; ++u) { const size_t cc = c + u * ngt; if (cc < nchunk) {
                v4u w; w.x = pk2(a[u].x, a[u].y); w.y = pk2(a[u].z, a[u].w); w.z = pk2(b[u].x, b[u].y); w.w = pk2(b[u].z, b[u].w); ((v4u*)XN)[cc] = w; } }
        }
    } else if constexpr (OP == 1) {
        pg8::Gemm g{XN, (const bf16*)(ws + WS_WIN + (size_t)V * WIN_BYTES), M, 2 * DFF, DM}; pg8::StaticOrder S; S.init(M, 2 * DFF, G, bx);
        pg8::EpiSwiglu E{HB, DFF};
        pg8::gemm_phase<pg8::EpiSwiglu, pg8::StaticOrder, true, true>(lds, g, S, E);
    } else if constexpr (OP == 2) {
        pg8::StaticOrder S; S.init(M, DM, G, bx);
        pg8::EpiBf16 E{OP4, DM, 0, 0};
        if constexpr (V < 4) { pg8::Gemm g{HB, (const bf16*)(ws + WS_WOUT + (size_t)V * WOUT_BYTES), M, DM, DFF};
            pg8::gemm_phase<pg8::EpiBf16, pg8::StaticOrder, true, true>(lds, g, S, E);
        } else { pg8::Gemm g{OB, (const bf16*)(ws + (V == 4 ? WS_WAO : WS_WBO)), M, DM, DM};
            pg8::gemm_phase<pg8::EpiBf16, pg8::StaticOrder, true, true>(lds, g, S, E); }
    } else if constexpr (OP == 3) {
        const float* lg = C.in[5] + (size_t)V * DM; const float* lb = C.in[6] + (size_t)V * DM;
        const float scale = (V % 3 == 1) ? 1.0f : 0.5f; unsigned* XL = (unsigned*)(ws + WS_XL);
        for (int m = gw * 4; m < M; m += ngw * 4) ln_rows4<FIRST, V == 5>(C.in[0] + (size_t)m * DM, OP4 + (size_t)m * DM, scale, X32 + (size_t)m * DM, XN + (size_t)m * DM, XL + (size_t)m * 64, lg, lb, lane);
    } else if constexpr (OP == 4) {
        if constexpr (V == 0) { pg8::Gemm g{XN, (const bf16*)(ws + WS_WQKV), M, 3 * DM, DM}; pg8::StaticOrder S; S.init(M, 3 * DM, G, bx);
            pg8::EpiHeads E{QB, (size_t)M * HD, att::SC2, 16};
            pg8::gemm_phase<pg8::EpiHeads, pg8::StaticOrder, true, true>(lds, g, S, E);
        } else if constexpr (V == 1) { pg8::Gemm g{XN, (const bf16*)(ws + WS_WKV), M, 512, DM}; pg8::StaticOrder S; S.init(M, 512, G, bx);
            pg8::EpiHeads E{KSH, (size_t)M * HD, 1.0f, 0};
            pg8::gemm_phase<pg8::EpiHeads, pg8::StaticOrder, true, true>(lds, g, S, E);
        } else { pg8::Gemm g{XN, (const bf16*)(ws + WS_WBQ), M, DM, DM}; pg8::StaticOrder S; S.init(M, DM, G, bx);
            pg8::EpiHeads E{QB, (size_t)M * HD, att::SC2, 16};
            pg8::gemm_phase<pg8::EpiHeads, pg8::StaticOrder, true, true>(lds, g, S, E); }
    } else {
        int tid_ = C.tid; asm volatile("" : "+v"(tid_));
        if constexpr (V == 0) att::wg_attention<0>(lds, tid_, G, bx, QB, KB, VB, OB, OP4, OP16, LSE4, LSE16, nullptr);
        else if constexpr (V == 1) att::wg_attention<1>(lds, tid_, G, bx, QB, KB, VB, OB, OP4, OP16, LSE4, LSE16, nullptr);
        else att::wg_attention<2>(lds, tid_, G, bx, QB, KSH, VSH, OB, OP4, OP16, LSE4, LSE16, C.in[11]);
    }
}

__global__ void __launch_bounds__(NWAVES * 64, 2) yoco_fwd(Args args) {
    extern __shared__ __attribute__((aligned(16))) unsigned char lds_raw[];
    cg::grid_group grid = cg::this_grid();
    Ctx C;
    C.lds = (LAS unsigned char*)lds_raw;
    C.tid = threadIdx.x; C.lane = C.tid & 63; C.wave = __builtin_amdgcn_readfirstlane(C.tid >> 6);
    C.G = gridDim.x; C.bx = blockIdx.x; C.gw = C.bx * NWAVES + C.wave; C.ngw = C.G * NWAVES;
    C.ws = args.ws; C.X32 = args.out;
#pragma unroll
    for (int i = 0; i < 13; ++i) C.in[i] = args.in[i];
    volatile LAS unsigned* misc = (volatile LAS unsigned*)(C.lds + LDS_BYTES - 64);
    if (C.tid < 16) misc[C.tid] = 0u;
    __syncthreads();
    XcdBarrier bar = xcd_barrier_post((unsigned*)(args.ws + WS_CTL) + 4096, misc + 8);
#define PH(op, v, first) phase<op, v, first>(C); GRID_SYNC();
    if (args.out == nullptr) grid.sync();
    PH(0, 0, false)
    PH(1, 0, false) PH(2, 0, false) PH(3, 0, true)
    PH(4, 0, false) PH(5, 0, false) PH(5, 1, false) PH(2, 4, false) PH(3, 1, false)
    PH(1, 2, false) PH(2, 2, false) PH(3, 2, false)
    phase<4, 1, false>(C);
    PH(1, 1, false) PH(2, 1, false) PH(3, 3, false)
    PH(4, 2, false) PH(5, 2, false) PH(2, 5, false) PH(3, 4, false)
    PH(1, 3, false) PH(2, 3, false)
    phase<3, 5, false>(C);
#undef PH
}

static_assert(att::WG_LDS_END + 64 <= LDS_BYTES, "attention LDS map");

extern "C" void kernel_launch(void* const* d_in, const int* in_sizes, int n_in, void* d_out, int out_size, void* d_ws, size_t ws_size, hipStream_t stream) {
    static int grid = 0;
    if (grid == 0) {
        if (n_in != 13 || in_sizes[0] != M * DM || out_size != M * DM || ws_size < WS_END) { fprintf(stderr, "kernel_launch: unexpected shapes / workspace (n_in %d, ws %zu, need %zu)\n", n_in, ws_size, (size_t)WS_END); grid = -1; return; }
        int dev = 0, cus = 0, per_cu = 0;
        hipGetDevice(&dev); hipDeviceGetAttribute(&cus, hipDeviceAttributeMultiprocessorCount, dev);
        if (hipFuncSetAttribute((const void*)yoco_fwd, hipFuncAttributeMaxDynamicSharedMemorySize, LDS_BYTES) != hipSuccess) { fprintf(stderr, "kernel_launch: hipFuncSetAttribute failed\n"); grid = -1; return; }
        hipOccupancyMaxActiveBlocksPerMultiprocessor(&per_cu, (const void*)yoco_fwd, NWAVES * 64, LDS_BYTES);
        (void)hipGetLastError();
        if (per_cu < 1) { fprintf(stderr, "kernel_launch: occupancy query says %d blocks per CU\n", per_cu); }
        grid = cus;
    }
    if (grid < 0) return;
    if (hipMemsetAsync((char*)d_ws + WS_CTL, 0, 65536, stream) != hipSuccess) { fprintf(stderr, "kernel_launch: memset of the control words failed\n"); return; }
    Args a{};
    for (int i = 0; i < 13; ++i) a.in[i] = (const float*)d_in[i];
    a.out = (float*)d_out; a.ws = (unsigned char*)d_ws;
    void* kargs[] = {&a};
    hipError_t e = hipLaunchCooperativeKernel((const void*)yoco_fwd, dim3(grid), dim3(NWAVES * 64), kargs, LDS_BYTES, stream);
    if (e != hipSuccess) fprintf(stderr, "cooperative launch failed: %s (grid %d)\n", hipGetErrorString(e), grid);
}
```

```cpp
#include <hip/hip_runtime.h>
#include <hip/hip_cooperative_groups.h>
#include <cstdio>
#include <cstdint>
#include <cmath>
namespace cg = cooperative_groups;
namespace pg8 {
#define PG8_LAS __attribute__((address_space(3)))
typedef unsigned short bf16_t;
typedef short bf16x8 __attribute__((ext_vector_type(8)));
typedef float f32x4 __attribute__((ext_vector_type(4)));
typedef unsigned u32x4 __attribute__((ext_vector_type(4)));
constexpr int BM = 256, BK = 64, HALF = 128, HTB = HALF * BK * 2  , STAGE_BYTES = 8 * HTB, NXCD = 8, WGM = 8;

__host__ __device__ __forceinline__ int lds_byte(int r, int c) { const int st = (r >> 4) * 2 + (c >> 5), rr = r & 15, cc = c & 31, ob = rr * 64 + cc * 2; return st * 1024 + (ob ^ (((ob >> 9) & 1) << 5)); }
__host__ __device__ __forceinline__ void stage_rc(int b, int& R, int& C) { const int st = b / 1024, sb = b % 1024, swz = sb ^ (((sb >> 9) & 1) << 5); R = (st >> 1) * 16 + swz / 64; C = (st & 1) * 32 + (swz % 64) / 2; }
__host__ __device__ __forceinline__ int perm32(int rho) { const int n = rho >> 4, i = rho & 15; return 8 * (i >> 2) + 4 * n + (i & 3); }

struct Unit { int pm, pn; };
struct Gemm { const bf16_t* A; const bf16_t* Bt; int M, N, K; };

struct StaticOrder {
    int nM, nN, nwg, G, c;
    __host__ __device__ void init(int M, int N, int G_, int c_) { nM = M / BM; nN = N / BM; nwg = nM * nN; G = G_; c = c_; }
    __host__ __device__ bool next(int i, Unit& u) const {
        const long L = (long)i * G + c; if (L >= nwg) return false;
        int wgid = (int)L; { const int q = nwg / NXCD, r = nwg % NXCD, xcd = wgid % NXCD, off = wgid / NXCD; wgid = (xcd < r ? xcd * (q + 1) : r * (q + 1) + (xcd - r) * q) + off; }
        const int nig = WGM * nN, gid = wgid / nig, fm = gid * WGM, gsz = (nM - fm) < WGM ? (nM - fm) : WGM;
        u.pm = fm + ((wgid % nig) % gsz); u.pn = (wgid % nig) / gsz; return true;
    }
    __device__ __forceinline__ void a_ready(const Unit&) const {}
    __device__ __forceinline__ void done(const Unit&) const {}
};


typedef float cvt_f32x2 __attribute__((ext_vector_type(2))); typedef __bf16 cvt_bf16x2 __attribute__((ext_vector_type(2)));
__device__ __forceinline__ unsigned cvt_pk_bf16_safe(float lo, float hi) { const cvt_f32x2 v = {lo, hi}; const cvt_bf16x2 b = __builtin_convertvector(v, cvt_bf16x2); return __builtin_bit_cast(unsigned, b); }
__device__ __forceinline__ unsigned cvt_pk_bf16(float lo, float hi) { unsigned r; asm volatile("v_cvt_pk_bf16_f32 %0, %1, %2" : "=v"(r) : "v"(lo), "v"(hi)); return r; }
#define MFMA_RESULT_GUARD(x) asm volatile("s_nop 15\n\ts_nop 7" :: "v"(x))
typedef unsigned u32x2 __attribute__((ext_vector_type(2)));

struct EpiBf16 {
    static constexpr bool PERM = true, AFTER_DRAIN = false;
    bf16_t* O; int ldc; int split_cols; size_t split_stride;
    __device__ __forceinline__ void operator()(const f32x4 (&acc)[2][2][4][2], const Unit& u, int wr, int wc, int fr, int fq) const {
        const int row0 = u.pm * BM + wr * 64 + fr; int colt = u.pn * BM; bf16_t* base = O;
        if (split_cols) { const int t = colt / split_cols; base += (size_t)t * split_stride; colt -= t * split_cols; }
        const int col0 = colt + wc * 32 + 8 * fq;
        asm volatile("s_nop 15\n\ts_nop 7" :: "v"(acc[1][1][0][0]), "v"(acc[1][1][0][1]), "v"(acc[1][1][1][0]), "v"(acc[1][1][1][1]), "v"(acc[1][1][2][0]), "v"(acc[1][1][2][1]), "v"(acc[1][1][3][0]), "v"(acc[1][1][3][1]));
#pragma unroll
        for (int ai = 0; ai < 2; ++ai)
#pragma unroll
            for (int m = 0; m < 4; ++m) { bf16_t* rowp = base + (size_t)(row0 + ai * HALF + m * 16) * ldc + col0;
#pragma unroll
                for (int bj = 0; bj < 2; ++bj) { const f32x4 v0 = acc[ai][bj][m][0], v1 = acc[ai][bj][m][1];
                    u32x4 w; w.x = cvt_pk_bf16(v0[0], v0[1]); w.y = cvt_pk_bf16(v0[2], v0[3]); w.z = cvt_pk_bf16(v1[0], v1[1]); w.w = cvt_pk_bf16(v1[2], v1[3]);
                    *(u32x4*)(rowp + bj * HALF) = w; } }
    }
};

struct EpiHeads {
    static constexpr bool PERM = true, AFTER_DRAIN = false;
    bf16_t* O; size_t head_stride; float scale0; int scale_heads;
    __device__ __forceinline__ void operator()(const f32x4 (&acc)[2][2][4][2], const Unit& u, int wr, int wc, int fr, int fq) const {
        const int row0 = u.pm * BM + wr * 64 + fr;
#pragma unroll
        for (int bj = 0; bj < 2; ++bj) { const int col = u.pn * BM + bj * HALF + wc * 32 + 8 * fq;
            bf16_t* hp = O + (size_t)(col >> 6) * head_stride + (col & 63); const float sc = ((col >> 6) < scale_heads) ? scale0 : 1.0f;
#pragma unroll
            for (int ai = 0; ai < 2; ++ai)
#pragma unroll
                for (int m = 0; m < 4; ++m) { const f32x4 v0 = acc[ai][bj][m][0] * sc, v1 = acc[ai][bj][m][1] * sc;
                    u32x4 w; w.x = cvt_pk_bf16(v0[0], v0[1]); w.y = cvt_pk_bf16(v0[2], v0[3]); w.z = cvt_pk_bf16(v1[0], v1[1]); w.w = cvt_pk_bf16(v1[2], v1[3]);
                    *(u32x4*)(hp + (size_t)(row0 + ai * HALF + m * 16) * 64) = w; } }
    }
};

struct EpiSwiglu {
    static constexpr bool PERM = false, AFTER_DRAIN = false;
    bf16_t* H; int ldh;
    __device__ __forceinline__ void operator()(const f32x4 (&acc)[2][2][4][2], const Unit& u, int wr, int wc, int fr, int fq) const {
        const int row0 = u.pm * BM + wr * 64 + fr; const int hcol0 = u.pn * 128 + wc * 16 + 4 * fq;
#pragma unroll
        for (int ai = 0; ai < 2; ++ai)
#pragma unroll
            for (int m = 0; m < 4; ++m) { bf16_t* rowp = H + (size_t)(row0 + ai * HALF + m * 16) * ldh + hcol0;
#pragma unroll
                for (int bj = 0; bj < 2; ++bj) { const f32x4 g = acc[ai][bj][m][0], up = acc[ai][bj][m][1]; float h[4];
#pragma unroll
                    for (int i = 0; i < 4; ++i) { const float e = __builtin_amdgcn_exp2f(g[i] * -1.4426950408889634f); h[i] = g[i] * __builtin_amdgcn_rcpf(1.0f + e) * up[i]; }
                    u32x2 w; w.x = cvt_pk_bf16(h[0], h[1]); w.y = cvt_pk_bf16(h[2], h[3]);
                    *(u32x2*)(rowp + bj * 64) = w; } }
    }
};

struct EpiResid {
    static constexpr bool PERM = false, AFTER_DRAIN = false;
    const float* base; float* out; float alpha, scale; int ldc;
    __device__ __forceinline__ void operator()(const f32x4 (&acc)[2][2][4][2], const Unit& u, int wr, int wc, int fr, int fq) const {
        const int row0 = u.pm * BM + wr * 64 + fr; const int col0 = u.pn * BM + wc * 32 + 4 * fq;
#pragma unroll
        for (int ai = 0; ai < 2; ++ai)
#pragma unroll
            for (int m = 0; m < 4; ++m) { const size_t off = (size_t)(row0 + ai * HALF + m * 16) * ldc + col0;
                f32x4 b[2][2];
#pragma unroll
                for (int bj = 0; bj < 2; ++bj)
#pragma unroll
                    for (int n = 0; n < 2; ++n) b[bj][n] = *(const f32x4*)(base + off + bj * HALF + n * 16);
#pragma unroll
                for (int bj = 0; bj < 2; ++bj)
#pragma unroll
                    for (int n = 0; n < 2; ++n) *(f32x4*)(out + off + bj * HALF + n * 16) = b[bj][n] * alpha + acc[ai][bj][m][n] * scale; }
    }
};

template <class Epi, class Sched, bool ALIGN_EPI = false, bool SP2 = false>
__device__ __forceinline__ void gemm_phase(PG8_LAS unsigned char* lds, const Gemm g, const Sched& S, const Epi& E) {
    int tid_ = threadIdx.x; asm volatile("" : "+v"(tid_));
    const int tid = tid_, wid = __builtin_amdgcn_readfirstlane(tid >> 6), lane = tid & 63, wr = wid >> 2, wc = wid & 3, fr = lane & 15, fq = lane >> 4;
    const int K = g.K, nt = K / BK;
    unsigned voffA[2], voffB[2];
#pragma unroll
    for (int i = 0; i < 2; ++i) { int R, C; stage_rc(tid * 16 + i * 8192, R, C); const int Rb = Epi::PERM ? ((R & ~31) + perm32(R & 31)) : R;
        voffA[i] = (unsigned)(R * K + C) * 2u; voffB[i] = (unsigned)(Rb * K + C) * 2u; }
    const size_t kstep = (size_t)(BK * 2);
    const size_t hstep = (size_t)HALF * K * 2;
    const size_t tstep = 2 * hstep;
    const unsigned ldsw = (unsigned)wid * 1024u;
    const int aoff = lds_byte(wr * 64 + fr, fq * 8), boff = lds_byte(wc * 32 + fr, fq * 8);
#define PG8_SA(b, h) (((b) * 2 + (h)) * HTB)
#define PG8_SB(b, h) ((4 + (b) * 2 + (h)) * HTB)
#define PG8_STAGE(bufoff, gbase, voff) do { _Pragma("unroll") for (int _i = 0; _i < 2; ++_i) \
        __builtin_amdgcn_global_load_lds((const unsigned*)((const char*)(gbase) + (voff)[_i]), (PG8_LAS unsigned*)(lds + (bufoff) + ldsw + _i * 8192), 16, 0, 0); } while (0)
#define PG8_LDA(dst, b, h) do { _Pragma("unroll") for (int m = 0; m < 4; ++m) _Pragma("unroll") for (int k = 0; k < 2; ++k) dst[m][k] = *(const PG8_LAS bf16x8*)(lds + PG8_SA(b, h) + aoff + m * 2048 + k * 1024); } while (0)
#define PG8_LDB(dst, b, h) do { _Pragma("unroll") for (int n = 0; n < 2; ++n) _Pragma("unroll") for (int k = 0; k < 2; ++k) dst[n][k] = *(const PG8_LAS bf16x8*)(lds + PG8_SB(b, h) + boff + n * 2048 + k * 1024); } while (0)
#define PG8_MMA(ai, bj, At, Bt) do { __builtin_amdgcn_s_setprio(1); _Pragma("unroll") for (int m = 0; m < 4; ++m) _Pragma("unroll") for (int n = 0; n < 2; ++n) _Pragma("unroll") for (int k = 0; k < 2; ++k) \
        acc[ai][bj][m][n] = __builtin_amdgcn_mfma_f32_16x16x32_bf16(Bt[n][k], At[m][k], acc[ai][bj][m][n], 0, 0, 0); __builtin_amdgcn_s_setprio(0); } while (0)
#define PG8_WAIT_V(n) asm volatile("s_waitcnt vmcnt(" #n ")" ::: "memory")
#define PG8_WAIT_L(n) asm volatile("s_waitcnt lgkmcnt(" #n ")" ::: "memory")
#define PG8_BAR __builtin_amdgcn_s_barrier()
#define PG8_SCHED __builtin_amdgcn_sched_barrier(0)
    Unit cur, nxt; int ui = 0;
    if (!S.next(0, cur)) return;
    f32x4 acc[2][2][4][2];
#pragma unroll
    for (int a = 0; a < 2; ++a)
#pragma unroll
        for (int b = 0; b < 2; ++b)
#pragma unroll
            for (int m = 0; m < 4; ++m)
#pragma unroll
                for (int n = 0; n < 2; ++n) acc[a][b][m][n] = (f32x4){0.f, 0.f, 0.f, 0.f};
    bf16x8 At[4][2], B0[2][2], B1[2][2];
    const char* cA = (const char*)g.A + (size_t)cur.pm * tstep; const char* cB = (const char*)g.Bt + (size_t)cur.pn * tstep;
    S.a_ready(cur);
    if constexpr (SP2) {
        PG8_STAGE(PG8_SB(0, 0), cB, voffB); PG8_STAGE(PG8_SB(0, 1), cB + hstep, voffB); PG8_STAGE(PG8_SA(0, 0), cA, voffA); PG8_STAGE(PG8_SA(0, 1), cA + hstep, voffA);
        if (wr == 1) PG8_BAR;
        PG8_WAIT_V(2); PG8_BAR;
        PG8_STAGE(PG8_SB(1, 0), cB + kstep, voffB); PG8_STAGE(PG8_SA(1, 0), cA + kstep, voffA); PG8_STAGE(PG8_SB(1, 1), cB + hstep + kstep, voffB);
        PG8_WAIT_V(6); PG8_BAR;
    } else {
        PG8_STAGE(PG8_SB(0, 0), cB, voffB); PG8_STAGE(PG8_SA(0, 0), cA, voffA); PG8_STAGE(PG8_SB(0, 1), cB + hstep, voffB); PG8_STAGE(PG8_SA(0, 1), cA + hstep, voffA);
        if (wr == 1) PG8_BAR;
        PG8_WAIT_V(4); PG8_BAR;
        PG8_STAGE(PG8_SB(1, 0), cB + kstep, voffB); PG8_STAGE(PG8_SA(1, 0), cA + kstep, voffA); PG8_STAGE(PG8_SB(1, 1), cB + hstep + kstep, voffB);
        PG8_WAIT_V(6); PG8_BAR;
    }
    for (;;) {
        const bool has_next = S.next(ui + 1, nxt);
        const char* nA = has_next ? (const char*)g.A + (size_t)nxt.pm * tstep : cA; const char* nB = has_next ? (const char*)g.Bt + (size_t)nxt.pn * tstep : cB;
        for (int t = 0; t < nt; t += 2) {
            const bool last = (t == nt - 2);
            const char* a1 = cA + (size_t)(t + 1) * kstep;
            const char* a2 = last ? nA : cA + (size_t)(t + 2) * kstep; const char* b2 = last ? nB : cB + (size_t)(t + 2) * kstep;
            const char* a3 = a2 + kstep; const char* b3 = b2 + kstep;
            if (last && has_next) S.a_ready(nxt);
            if constexpr (SP2) {
            PG8_LDB(B0, 0, 0); PG8_LDB(B1, 0, 1); PG8_SCHED; PG8_LDA(At, 0, 0); PG8_STAGE(PG8_SA(1, 1), a1 + hstep, voffA);
            PG8_WAIT_V(8); PG8_WAIT_L(0); PG8_BAR; PG8_MMA(0, 0, At, B0); PG8_MMA(0, 1, At, B1); PG8_BAR; PG8_SCHED;
            PG8_LDA(At, 0, 1); PG8_STAGE(PG8_SB(0, 0), b2, voffB); PG8_STAGE(PG8_SB(0, 1), b2 + hstep, voffB); PG8_STAGE(PG8_SA(0, 0), a2, voffA);
            PG8_WAIT_V(8); PG8_WAIT_L(0); PG8_BAR; PG8_MMA(1, 0, At, B0); PG8_MMA(1, 1, At, B1); PG8_BAR; PG8_SCHED;
            PG8_LDB(B0, 1, 0); PG8_LDB(B1, 1, 1); PG8_SCHED; PG8_LDA(At, 1, 0); PG8_STAGE(PG8_SA(0, 1), a2 + hstep, voffA);
            PG8_WAIT_V(8); PG8_WAIT_L(0); PG8_BAR; PG8_MMA(0, 0, At, B0); PG8_MMA(0, 1, At, B1); PG8_BAR; PG8_SCHED;
            PG8_LDA(At, 1, 1); PG8_STAGE(PG8_SB(1, 0), b3, voffB); PG8_STAGE(PG8_SB(1, 1), b3 + hstep, voffB); PG8_STAGE(PG8_SA(1, 0), a3, voffA);
            PG8_WAIT_V(8); PG8_WAIT_L(0); PG8_BAR; PG8_MMA(1, 0, At, B0); PG8_MMA(1, 1, At, B1); PG8_BAR; PG8_SCHED;
            } else {
            PG8_LDB(B0, 0, 0); PG8_SCHED; PG8_LDA(At, 0, 0); PG8_STAGE(PG8_SA(1, 1), a1 + hstep, voffA);
            PG8_WAIT_L(8); PG8_BAR; PG8_WAIT_L(0); PG8_MMA(0, 0, At, B0); PG8_BAR; PG8_SCHED;
            PG8_LDB(B1, 0, 1); PG8_STAGE(PG8_SB(0, 0), b2, voffB);
            PG8_BAR; PG8_WAIT_L(0); PG8_MMA(0, 1, At, B1); PG8_BAR;
            PG8_LDA(At, 0, 1); PG8_STAGE(PG8_SA(0, 0), a2, voffA);
            PG8_BAR; PG8_WAIT_L(0); PG8_MMA(1, 0, At, B0); PG8_BAR; PG8_SCHED;
            PG8_STAGE(PG8_SB(0, 1), b2 + hstep, voffB);
            PG8_WAIT_V(6); PG8_BAR; PG8_MMA(1, 1, At, B1); PG8_BAR;
            PG8_LDB(B0, 1, 0); PG8_SCHED; PG8_LDA(At, 1, 0); PG8_STAGE(PG8_SA(0, 1), a2 + hstep, voffA);
            PG8_WAIT_L(8); PG8_BAR; PG8_WAIT_L(0); PG8_MMA(0, 0, At, B0); PG8_BAR; PG8_SCHED;
            PG8_LDB(B1, 1, 1); PG8_STAGE(PG8_SB(1, 0), b3, voffB);
            PG8_BAR; PG8_WAIT_L(0); PG8_MMA(0, 1, At, B1); PG8_BAR;
            PG8_LDA(At, 1, 1); PG8_STAGE(PG8_SA(1, 0), a3, voffA);
            PG8_BAR; PG8_WAIT_L(0); PG8_MMA(1, 0, At, B0); PG8_BAR; PG8_SCHED;
            PG8_STAGE(PG8_SB(1, 1), b3 + hstep, voffB);
            PG8_WAIT_V(6); PG8_BAR; PG8_MMA(1, 1, At, B1); PG8_BAR;
            }
        }
        if constexpr (ALIGN_EPI) { if (wr == 0) PG8_BAR; }
        if constexpr (!Epi::AFTER_DRAIN) { E(acc, cur, wr, wc, fr, fq); S.done(cur); }
        if (!has_next) break;
#pragma unroll
        for (int a = 0; a < 2; ++a)
#pragma unroll
            for (int b = 0; b < 2; ++b)
#pragma unroll
                for (int m = 0; m < 4; ++m)
#pragma unroll
                    for (int n = 0; n < 2; ++n) acc[a][b][m][n] = (f32x4){0.f, 0.f, 0.f, 0.f};
        cur = nxt; cA = nA; cB = nB; ++ui;
        if constexpr (ALIGN_EPI) { if (wr == 1) PG8_BAR; }
    }
    PG8_WAIT_V(0);
    if constexpr (!ALIGN_EPI) { if (wr == 0) PG8_BAR; }
    PG8_BAR;
    if constexpr (Epi::AFTER_DRAIN) { E.fused(acc, cur, wr, wc, fr, fq, lds, wid, lane); S.done(cur); }
#undef PG8_SA
#undef PG8_SB
#undef PG8_STAGE
#undef PG8_LDA
#undef PG8_LDB
#undef PG8_MMA
#undef PG8_WAIT_V
#undef PG8_WAIT_L
#undef PG8_BAR
#undef PG8_SCHED
}
}

constexpr int NB = 8, SEQ = 4096, DM = 1024, DFF = 2816, NH = 16, HD = 64, NKV = 4;
constexpr int M = NB * SEQ;
constexpr float LN_EPS = 1e-5f;
constexpr float ALPHA = 1.41421356237309515f;
constexpr int NWAVES = 8;
constexpr int LDS_BYTES = 155648;

#define GAS __attribute__((address_space(1)))
#define LAS __attribute__((address_space(3)))
typedef unsigned short bf16;
typedef unsigned v4u __attribute__((ext_vector_type(4)));
typedef unsigned v2u __attribute__((ext_vector_type(2)));
typedef float f32x4 __attribute__((ext_vector_type(4)));
typedef short bf16x8 __attribute__((ext_vector_type(8)));
typedef short s16x4 __attribute__((ext_vector_type(4)));
typedef float f32x16 __attribute__((ext_vector_type(16)));
#define LDS_WAIT() asm volatile("s_waitcnt lgkmcnt(0)" ::: "memory")

constexpr size_t MiB = 1u << 20;
constexpr size_t WS_CTL = 0;
constexpr size_t WS_WIN = 1 * MiB;
constexpr size_t WIN_BYTES = (size_t)2 * DFF * DM * 2;
constexpr size_t WS_WOUT = WS_WIN + 4 * WIN_BYTES;
constexpr size_t WOUT_BYTES = (size_t)DM * DFF * 2;
constexpr size_t WS_WQKV = WS_WOUT + 4 * WOUT_BYTES;
constexpr size_t WS_WAO = WS_WQKV + 6 * MiB;
constexpr size_t WS_WKV = WS_WAO + 2 * MiB;
constexpr size_t WS_WBQ = WS_WKV + 1 * MiB;
constexpr size_t WS_WBO = WS_WBQ + 2 * MiB;
constexpr size_t WS_KVSH = 80 * MiB;
constexpr size_t WS_XN = 112 * MiB;
constexpr size_t WS_BIG = 176 * MiB;
constexpr size_t WS_Q = WS_BIG, WS_K = WS_BIG + 64 * MiB, WS_V = WS_BIG + 128 * MiB, WS_OP4 = WS_BIG + 192 * MiB, WS_LSE4 = WS_BIG + 256 * MiB, WS_LSE16 = WS_BIG + 258 * MiB;
constexpr size_t WS_XL = WS_BIG + 260 * MiB;
constexpr size_t WS_END = WS_XL + 32 * MiB;
static_assert(WS_WBO + 2 * MiB <= WS_KVSH, "weight copies fit below KVSH");

__device__ __forceinline__ unsigned f2bf(float f) { unsigned u = __builtin_bit_cast(unsigned, f); return (u + 0x7fffu + ((u >> 16) & 1u)) >> 16; }
__device__ __forceinline__ unsigned pk2(float lo, float hi) { return f2bf(lo) | (f2bf(hi) << 16); }
__device__ __forceinline__ float bf2f(unsigned short b) { return __builtin_bit_cast(float, (unsigned)b << 16); }

template <bool SWI>
__device__ __forceinline__ void transpose_item(const float* W, int K, int N, bf16* WT, LAS float* scr, int item, int nblk, int lane) {
    const int kb = item / nblk, nb = item % nblk, k0 = 64 * kb, n0 = 32 * nb;
    const int j = lane & 31;
    const int scol = SWI ? (nb * 16 + (j & 15) + ((j & 16) ? DFF : 0)) : (n0 + j);
#pragma unroll
    for (int i = 0; i < 32; ++i) { const int kk = 2 * i + (lane >> 5); scr[kk * 33 + j] = W[(size_t)(k0 + kk) * N + scol]; }
    LDS_WAIT();
    const int c = lane & 7;
#pragma unroll
    for (int jj = 0; jj < 4; ++jj) { const int n = (lane >> 3) + 8 * jj; const LAS float* s = scr + (8 * c) * 33 + n;
        v4u o; o.x = pk2(s[0 * 33], s[1 * 33]); o.y = pk2(s[2 * 33], s[3 * 33]); o.z = pk2(s[4 * 33], s[5 * 33]); o.w = pk2(s[6 * 33], s[7 * 33]);
        *(v4u*)(WT + (size_t)(n0 + n) * K + k0 + 8 * c) = o; }
    LDS_WAIT();
}
template <bool SWI>
__device__ __forceinline__ void transpose_matrix(const float* W, int K, int N, bf16* WT, LAS float* scr, int gw, int ngw, int lane) {
    const int nblk = N / 32, nitems = (K / 64) * nblk;
    for (int it = gw; it < nitems; it += ngw) transpose_item<SWI>(W, K, N, WT, scr, it, nblk, lane);
}

constexpr int T_TOTAL = 4 * 2816 + 4 * 1408 + 1536 + 512 + 256 + 512 + 512;
struct TDesc { const float* W; bf16* WT; int K, N, k0, nb; bool swi; };
struct TIn { const float *w1in, *w1out, *w2in, *w2out, *qkv, *ao, *kv, *bq, *bo; };
__device__ __forceinline__ TDesc t_decode(const TIn in, unsigned char* ws, int it) {
    TDesc d; int r, nblk;
    const float *w1in = in.w1in, *w1out = in.w1out, *w2in = in.w2in, *w2out = in.w2out, *qkv = in.qkv, *ao = in.ao, *kv = in.kv, *bq = in.bq, *bo = in.bo;
    if (it < 11264) { const int m = it / 2816; r = it % 2816; d.K = DM; d.N = 2 * DFF; d.swi = true; nblk = 176;
        d.W = ((m >> 1) ? w2in : w1in) + (size_t)(m & 1) * DM * 2 * DFF; d.WT = (bf16*)(ws + WS_WIN + (size_t)m * WIN_BYTES); }
    else if (it < 16896) { const int q = it - 11264, m = q / 1408; r = q % 1408; d.K = DFF; d.N = DM; d.swi = false; nblk = 32;
        d.W = ((m >> 1) ? w2out : w1out) + (size_t)(m & 1) * DFF * DM; d.WT = (bf16*)(ws + WS_WOUT + (size_t)m * WOUT_BYTES); }
    else { const int q = it - 16896; d.K = DM; d.swi = false;
        if (q < 1536) { r = q; d.N = 3 * DM; nblk = 96; d.W = qkv; d.WT = (bf16*)(ws + WS_WQKV); }
        else if (q < 2048) { r = q - 1536; d.N = DM; nblk = 32; d.W = ao; d.WT = (bf16*)(ws + WS_WAO); }
        else if (q < 2304) { r = q - 2048; d.N = 512; nblk = 16; d.W = kv; d.WT = (bf16*)(ws + WS_WKV); }
        else if (q < 2816) { r = q - 2304; d.N = DM; nblk = 32; d.W = bq; d.WT = (bf16*)(ws + WS_WBQ); }
        else { r = q - 2816; d.N = DM; nblk = 32; d.W = bo; d.WT = (bf16*)(ws + WS_WBO); } }
    d.k0 = (r / nblk) * 64; d.nb = r % nblk; return d;
}
__device__ __forceinline__ void t_load(const TDesc& d, f32x4 (&v)[8], int lane) {
    const int j4 = 4 * (lane & 7);
    const int scol = d.swi ? (d.nb * 16 + (j4 & 15) + ((j4 & 16) ? DFF : 0)) : (d.nb * 32 + j4);
#pragma unroll
    for (int i = 0; i < 8; ++i) v[i] = __builtin_nontemporal_load((const f32x4*)(d.W + (size_t)(d.k0 + 8 * i + (lane >> 3)) * d.N + scol));
}
__device__ __forceinline__ void t_store(const TDesc& d, const f32x4 (&v)[8], LAS float* scr, int lane) {
    const int j4 = 4 * (lane & 7);
#pragma unroll
    for (int i = 0; i < 8; ++i) { LAS float* p = scr + (8 * i + (lane >> 3)) * 33 + j4; p[0] = v[i].x; p[1] = v[i].y; p[2] = v[i].z; p[3] = v[i].w; }
    LDS_WAIT();
    const int c = lane & 7;
#pragma unroll
    for (int jj = 0; jj < 4; ++jj) { const int n = (lane >> 3) + 8 * jj; const LAS float* s = scr + (8 * c) * 33 + n;
        v4u o; o.x = pk2(s[0 * 33], s[1 * 33]); o.y = pk2(s[2 * 33], s[3 * 33]); o.z = pk2(s[4 * 33], s[5 * 33]); o.w = pk2(s[6 * 33], s[7 * 33]);
        *(v4u*)(d.WT + (size_t)(d.nb * 32 + n) * d.K + d.k0 + 8 * c) = o; }
    LDS_WAIT();
}

__device__ __forceinline__ float wave_sum(float v) {
#pragma unroll
    for (int o = 1; o < 64; o <<= 1) v += __shfl_xor(v, o);
    return v;
}
__device__ __forceinline__ float res_dec(unsigned hi16, unsigned word, int sh) { const int d4 = (int)((word >> sh) << 28) >> 28; return __builtin_bit_cast(float, (hi16 << 16) + ((unsigned)d4 << 12)); }
__device__ __forceinline__ unsigned res_enc_lo(float x, unsigned hi16) {
    int d = (int)(__builtin_bit_cast(unsigned, x) - (hi16 << 16)); d = (d + 2048) >> 12; d = d < -8 ? -8 : (d > 7 ? 7 : d); return (unsigned)d & 0xfu; }
template <bool IN_F32, bool OUT_F32>
__device__ __forceinline__ void ln_rows4(const float* xin, const bf16* yrow, float scale, float* oout, bf16* xn, unsigned* xl, const float* g, const float* b, int lane) {
    f32x4 v[4][4]; v2u yv[4][4];
    if (IN_F32) {
#pragma unroll
        for (int r = 0; r < 4; ++r)
#pragma unroll
            for (int j = 0; j < 4; ++j) v[r][j] = __builtin_nontemporal_load((const f32x4*)(xin + (size_t)r * DM) + lane + 64 * j);
    } else {
        v2u hv[4][4], lv[4];
#pragma unroll
        for (int r = 0; r < 4; ++r) { lv[r] = __builtin_nontemporal_load((const v2u*)(xl + (size_t)r * 128) + lane);
#pragma unroll
            for (int j = 0; j < 4; ++j) hv[r][j] = __builtin_nontemporal_load((const v2u*)(xn + (size_t)r * DM) + lane + 64 * j); }
#pragma unroll
        for (int r = 0; r < 4; ++r)
#pragma unroll
            for (int j = 0; j < 4; ++j) { const unsigned h0 = hv[r][j].x, h1 = hv[r][j].y; const unsigned l = (j >> 1) ? lv[r].y : lv[r].x; const int sh = 16 * (j & 1);
                v[r][j] = (f32x4){res_dec(h0 & 0xffffu, l, sh), res_dec(h0 >> 16, l, sh + 4), res_dec(h1 & 0xffffu, l, sh + 8), res_dec(h1 >> 16, l, sh + 12)}; }
    }
#pragma unroll
    for (int r = 0; r < 4; ++r)
#pragma unroll
        for (int j = 0; j < 4; ++j) yv[r][j] = __builtin_nontemporal_load((const v2u*)(yrow + (size_t)r * DM) + lane + 64 * j);
    float mean[4], rstd[4];
#pragma unroll
    for (int r = 0; r < 4; ++r) { float s = 0.f;
#pragma unroll
        for (int j = 0; j < 4; ++j) { const f32x4 y = {__builtin_bit_cast(float, yv[r][j].x << 16), __builtin_bit_cast(float, yv[r][j].x & 0xffff0000u), __builtin_bit_cast(float, yv[r][j].y << 16), __builtin_bit_cast(float, yv[r][j].y & 0xffff0000u)};
            v[r][j] = v[r][j] * ALPHA + y * scale; s += (v[r][j].x + v[r][j].y) + (v[r][j].z + v[r][j].w); }
        mean[r] = wave_sum(s) * (1.f / DM); }
#pragma unroll
    for (int r = 0; r < 4; ++r) { float s2 = 0.f;
#pragma unroll
        for (int j = 0; j < 4; ++j) { v[r][j] = v[r][j] - mean[r]; s2 += (v[r][j].x * v[r][j].x + v[r][j].y * v[r][j].y) + (v[r][j].z * v[r][j].z + v[r][j].w * v[r][j].w); }
        rstd[r] = 1.f / sqrtf(wave_sum(s2) * (1.f / DM) + LN_EPS); }
    v2u xw[4];
#pragma unroll
    for (int r = 0; r < 4; ++r) xw[r] = (v2u){0u, 0u};
#pragma unroll
    for (int j = 0; j < 4; ++j) { const f32x4 gg = ((const f32x4*)g)[lane + 64 * j], bb = ((const f32x4*)b)[lane + 64 * j];
#pragma unroll
        for (int r = 0; r < 4; ++r) { const f32x4 y = v[r][j] * rstd[r] * gg + bb;
            if (OUT_F32) __builtin_nontemporal_store(y, (f32x4*)(oout + (size_t)r * DM) + lane + 64 * j);
            else { v2u w; w.x = pk2(y.x, y.y); w.y = pk2(y.z, y.w); ((v2u*)(xn + (size_t)r * DM))[lane + 64 * j] = w;
                const unsigned nib = (res_enc_lo(y.x, w.x & 0xffffu) | (res_enc_lo(y.y, w.x >> 16) << 4) | (res_enc_lo(y.z, w.y & 0xffffu) << 8) | (res_enc_lo(y.w, w.y >> 16) << 12)) << (16 * (j & 1));
                if (j >> 1) xw[r].y |= nib; else xw[r].x |= nib; } } }
    if (!OUT_F32) {
#pragma unroll
        for (int r = 0; r < 4; ++r) __builtin_nontemporal_store(xw[r], (v2u*)(xl + (size_t)r * 128) + lane);
    }
}

namespace att {
constexpr int VP = 144;
constexpr float SC2 = 0.125f * 1.4426950408889634f;
__device__ __forceinline__ int crow(int r, int hi) { return (r & 3) + 8 * (r >> 2) + 4 * hi; }
__device__ __forceinline__ unsigned cvtpk(float lo, float hi) { return pg8::cvt_pk_bf16(lo, hi); }
typedef short v4i16_t __attribute__((ext_vector_type(4)));
__device__ __forceinline__ s16x4 vtr(LAS const unsigned char* p) { return __builtin_bit_cast(s16x4, __builtin_amdgcn_ds_read_tr16_b64_v4i16((LAS v4i16_t*)p)); }

constexpr int TROWS = 384, KT_OFF = 0, VT_OFF = TROWS * VP, WV_OFF = 2 * TROWS * VP, WV_BYTES = 32 * VP + 512;
constexpr int WG_LDS_END = WV_OFF + 8 * WV_BYTES;
template <int MODE>
__device__ __forceinline__ void decode(int wt, int& b, int& h, int& d, int& r, int& Q0, int& pat) {
    if (MODE == 0) { pat = wt >> 11; int tt = wt & 2047; d = pat ? 4 : 16; const int nblk = pat ? 4 : 1;
        const int blk = tt % nblk; tt /= nblk; r = tt % d; tt /= d; h = tt & 15; b = tt >> 4; Q0 = blk * 256; }
    else { pat = 0; d = 1; r = 0; Q0 = (wt & 15) * 256; h = (wt >> 4) & 15; b = wt >> 8; }
}
template <int MODE>
__device__ __forceinline__ void wg_attention(LAS unsigned char* lds, int tid, int G, int bx,
        const bf16* QH, const bf16* KH, const bf16* VH,
        bf16* OB, bf16* OP4, bf16* OP16, float* LSE4, float* LSE16, const float* sinks) {
    const int lane = tid & 63, wave = __builtin_amdgcn_readfirstlane(tid >> 6), r32 = lane & 31, hi = lane >> 5;
    const int ntasks = (MODE == 0) ? 4096 : 2048;
    const float NEG = -INFINITY;
    LAS unsigned char* wv = lds + WV_OFF + wave * WV_BYTES;
    LAS float* wsf = (LAS float*)(wv + 32 * VP);
    v4u kreg[6], vreg[6], qreg[4];
    int b, h, d, r, Q0, pat;
#define ATT_PREFETCH(newt_) do { \
        const int kvh_ = (MODE == 2) ? (h >> 2) : h; \
        const bf16* Kp_ = KH + ((size_t)kvh_ * M + (size_t)b * SEQ) * HD; const bf16* Vp_ = VH + ((size_t)kvh_ * M + (size_t)b * SEQ) * HD; \
        const bf16* Qp_ = QH + ((size_t)h * M + (size_t)b * SEQ) * HD; \
        const unsigned toff_ = (unsigned)(((tid >> 3) * d * HD + 8 * (tid & 7)) * 2), loff_ = (unsigned)(((lane >> 3) * d * HD + 8 * (lane & 7)) * 2); \
        if (newt_) { _Pragma("unroll") for (int i = 0; i < 6; ++i) { const int row0_ = Q0 - 128 + 64 * i; \
            if (Q0 == 0 && i < 2) { kreg[i] = (v4u){0u, 0u, 0u, 0u}; vreg[i] = (v4u){0u, 0u, 0u, 0u}; }     \
            else { kreg[i] = __builtin_nontemporal_load((const v4u*)((const char*)(Kp_ + (r + (long)d * row0_) * HD) + toff_)); vreg[i] = __builtin_nontemporal_load((const v4u*)((const char*)(Vp_ + (r + (long)d * row0_) * HD) + toff_)); } } } \
        _Pragma("unroll") for (int i = 0; i < 4; ++i) qreg[i] = __builtin_nontemporal_load((const v4u*)((const char*)(Qp_ + (r + (long)d * (Q0 + 32 * wave + 8 * i)) * HD) + loff_)); } while (0)
#define ATT_TASK(it_, valid_, newt_) do { if (MODE == 2) { const int T_ = bx + G * ((it_) >> 2); valid_ = T_ < 512; newt_ = ((it_) & 3) == 0; \
            if (valid_) { pat = 0; d = 1; r = 0; Q0 = (T_ & 15) * 256; h = ((T_ >> 4) & 3) * 4 + ((it_) & 3); b = T_ >> 6; } } \
        else { const int wt_ = bx + (it_) * G; valid_ = wt_ < ntasks; newt_ = true; if (valid_) decode<MODE>(wt_, b, h, d, r, Q0, pat); } } while (0)
    int it = 0; bool valid, newt;
    ATT_TASK(0, valid, newt);
    if (valid) ATT_PREFETCH(newt);
    while (valid) {
        if (newt) {
#pragma unroll
            for (int i = 0; i < 6; ++i) { *(LAS v4u*)(lds + KT_OFF + ((tid >> 3) + 64 * i) * VP + 16 * (tid & 7)) = kreg[i]; *(LAS v4u*)(lds + VT_OFF + ((tid >> 3) + 64 * i) * VP + 16 * (tid & 7)) = vreg[i]; }
        }
#pragma unroll
        for (int i = 0; i < 4; ++i) *(LAS v4u*)(wv + ((lane >> 3) + 8 * i) * VP + 16 * (lane & 7)) = qreg[i];
        const int cb = b, ch = h, cd = d, cr = r, cQ0 = Q0, cpat = pat;
        const int q0 = cQ0 + 32 * wave;
        const float slope2 = exp2f(-0.5f * (float)(ch + 1)) * (float)cd * 1.4426950408889634f;
        const float sink2 = (MODE == 2) ? sinks[ch] * 1.4426950408889634f : 0.f;
        const int maxdist = (MODE == 2) ? 127 : 128;
        const size_t ro = (size_t)cb * SEQ * DM + ch * HD;
        const unsigned eoff = (unsigned)(((lane >> 3) * cd * DM + 8 * (lane & 7)) * 2);
        const long tq = cr + (long)cd * (q0 + r32);
        __syncthreads();
        bool nvalid, nnewt; ATT_TASK(it + 1, nvalid, nnewt);
        if (nvalid) ATT_PREFETCH(nnewt);
        __builtin_amdgcn_sched_barrier(0);
        bf16x8 qr[4];
#pragma unroll
        for (int d0 = 0; d0 < 4; ++d0) qr[d0] = *(LAS const bf16x8*)(wv + r32 * VP + hi * 16 + d0 * 32);
        int dbase = r32 + 128 - 4 * hi; asm volatile("" : "+v"(dbase));
        const float bias0 = -slope2 * (float)dbase;
        f32x16 base;
#pragma unroll
        for (int g = 0; g < 16; ++g) base[g] = fmaf(slope2, (float)((g & 3) + 8 * (g >> 2)), bias0);
        f32x16 S[5];
#pragma unroll
        for (int c = 0; c < 5; ++c) {
            LAS const unsigned char* kb = lds + KT_OFF + (32 * (wave + c) + r32) * VP + hi * 16;
            bf16x8 kf[4];
#pragma unroll
            for (int d0 = 0; d0 < 4; ++d0) kf[d0] = *(LAS const bf16x8*)(kb + d0 * 32);
            const float tc = ((q0 - 128 + 32 * c) >= 0) ? slope2 * (float)(32 * c) : NEG;
            f32x16 a;
#pragma unroll
            for (int g = 0; g < 16; ++g) a[g] = base[g] + tc;
#pragma unroll
            for (int d0 = 0; d0 < 4; ++d0) a = __builtin_amdgcn_mfma_f32_32x32x16_bf16(kf[d0], qr[d0], a, 0, 0, 0);
            S[c] = a;
        }
        __builtin_amdgcn_sched_barrier(0);
        v4u p4[4], p16[4]; float l4 = 0.f, l16 = 0.f;
        if (MODE == 1) {
            { const int s_ = (int)tq; l4 = LSE4[(((size_t)cb * NH + ch) * 4 + (s_ & 3)) * (SEQ / 4) + (s_ >> 2)]; l16 = LSE16[(((size_t)cb * NH + ch) * 16 + (s_ & 15)) * (SEQ / 16) + (s_ >> 4)]; }
#pragma unroll
            for (int i = 0; i < 4; ++i) { const size_t tokb = (ro + (size_t)(cr + (long)cd * (q0 + 8 * i)) * DM) * 2;
                p4[i] = __builtin_nontemporal_load((const v4u*)((const char*)OP4 + tokb + eoff)); p16[i] = __builtin_nontemporal_load((const v4u*)((const char*)OP16 + tokb + eoff)); }
        }
#pragma unroll
        for (int g = 0; g < 16; ++g) { const int ce = (g & 3) + 8 * (g >> 2);
            S[0][g] = (dbase - ce <= maxdist) ? S[0][g] : NEG;
            S[4][g] = (dbase - (128 + ce) >= 0) ? S[4][g] : NEG; }
        float m = NEG;
#pragma unroll
        for (int c = 0; c < 5; ++c) {
#pragma unroll
            for (int g = 0; g < 16; g += 2) m = fmaxf(fmaxf(m, S[c][g]), S[c][g + 1]);
        }
        __builtin_amdgcn_sched_barrier(0);
        m = fmaxf(m, __shfl_xor(m, 32));
        if (MODE == 2) m = fmaxf(m, sink2);
        typedef float f32x2 __attribute__((ext_vector_type(2)));
        const f32x2 mm = {m, m}; f32x2 ls = {0.f, 0.f};
        v4u pa[5][2];
#pragma unroll
        for (int c = 0; c < 5; ++c) {
#pragma unroll
            for (int s = 0; s < 2; ++s) { unsigned w[4];
#pragma unroll
                for (int k = 0; k < 4; ++k) { f32x2 v = {S[c][8 * s + 2 * k], S[c][8 * s + 2 * k + 1]}; v = v - mm;
                    f32x2 p; p.x = __builtin_amdgcn_exp2f(v.x); p.y = __builtin_amdgcn_exp2f(v.y); ls = ls + p; w[k] = cvtpk(p.x, p.y); }
                pa[c][s].x = w[0]; pa[c][s].y = w[1]; pa[c][s].z = w[2]; pa[c][s].w = w[3]; }
            __builtin_amdgcn_sched_barrier(0);
        }
        float l = ls.x + ls.y;
        l += __shfl_xor(l, 32);
        if (MODE == 2) l += __builtin_amdgcn_exp2f(sink2 - m);
        f32x16 o[2];
#pragma unroll
        for (int g = 0; g < 16; ++g) { o[0][g] = 0.f; o[1][g] = 0.f; }
        LAS const unsigned char* vrd = lds + VT_OFF + (32 * wave + 4 * hi + ((lane & 15) >> 2)) * VP + (16 * ((lane >> 4) & 1) + 4 * (lane & 3)) * 2;
#pragma unroll
        for (int c = 0; c < 5; ++c)
#pragma unroll
            for (int s = 0; s < 2; ++s)
#pragma unroll
                for (int d0 = 0; d0 < 2; ++d0) {
                    const s16x4 lo = vtr(vrd + (32 * c + 16 * s) * VP + 64 * d0), hh = vtr(vrd + (32 * c + 16 * s + 8) * VP + 64 * d0);
                    const bf16x8 vf = (bf16x8){lo[0], lo[1], lo[2], lo[3], hh[0], hh[1], hh[2], hh[3]};
                    o[d0] = __builtin_amdgcn_mfma_f32_32x32x16_bf16(__builtin_bit_cast(bf16x8, pa[c][s]), vf, o[d0], 0, 0, 0);
                }
        const float lse2 = m + __builtin_amdgcn_logf(l);
        if (MODE == 1) {
            const float mx = fmaxf(lse2, fmaxf(l4, l16));
            const float e1 = __builtin_amdgcn_exp2f(lse2 - mx), e4 = __builtin_amdgcn_exp2f(l4 - mx), e16 = __builtin_amdgcn_exp2f(l16 - mx);
            const float it = 1.0f / (e1 + e4 + e16);
            if (hi == 0) { wsf[r32] = e1 * it / l; wsf[32 + r32] = e4 * it; wsf[64 + r32] = e16 * it; }
        } else {
            if (hi == 0) { wsf[r32] = 1.0f / l; if (MODE == 0) (cpat ? LSE4 : LSE16)[(((size_t)cb * NH + ch) * cd + cr) * (SEQ / cd) + (q0 + r32)] = lse2; }
        }
        LAS unsigned short* stg = (LAS unsigned short*)wv;
        MFMA_RESULT_GUARD(o[0]); MFMA_RESULT_GUARD(o[1]);
#pragma unroll
        for (int g = 0; g < 16; ++g) { const int q = (g & 3) + 8 * (g >> 2) + 4 * hi; const unsigned w = cvtpk(o[0][g], o[1][g]);
            stg[q * (VP / 2) + r32] = (unsigned short)(w & 0xffffu); stg[q * (VP / 2) + 32 + r32] = (unsigned short)(w >> 16); }
        LDS_WAIT();
        bf16* Odst = (MODE == 0) ? (cpat ? OP4 : OP16) : OB;
#pragma unroll
        for (int i = 0; i < 4; ++i) {
            const int row = (lane >> 3) + 8 * i;
            const size_t tokb = (ro + (size_t)(cr + (long)cd * (q0 + 8 * i)) * DM) * 2;
            const float f = wsf[row];
            const v4u ov = *(LAS const v4u*)(wv + row * VP + 16 * (lane & 7));
            float v[8];
#pragma unroll
            for (int j = 0; j < 4; ++j) { v[2 * j] = __builtin_bit_cast(float, ov[j] << 16) * f; v[2 * j + 1] = __builtin_bit_cast(float, ov[j] & 0xffff0000u) * f; }
            if (MODE == 1) { const float w4 = wsf[32 + row], w16 = wsf[64 + row];
#pragma unroll
                for (int j = 0; j < 4; ++j) { v[2 * j] += w4 * __builtin_bit_cast(float, p4[i][j] << 16) + w16 * __builtin_bit_cast(float, p16[i][j] << 16);
                                               v[2 * j + 1] += w4 * __builtin_bit_cast(float, p4[i][j] & 0xffff0000u) + w16 * __builtin_bit_cast(float, p16[i][j] & 0xffff0000u); } }
            v4u w; w.x = cvtpk(v[0], v[1]); w.y = cvtpk(v[2], v[3]); w.z = cvtpk(v[4], v[5]); w.w = cvtpk(v[6], v[7]);
            *(v4u*)((char*)Odst + tokb + eoff) = w;
        }
        __syncthreads();
        valid = nvalid; newt = nnewt; ++it;
    }
#undef ATT_PREFETCH
#undef ATT_TASK
}
}

typedef GAS unsigned gu32;
#define XB_TMO      128
#define XB_XCNT(j)  (256  + 64 * (j))
#define XB_XSUB(j)  (1280 + 64 * (j))
#define XB_XGEN(j)  (2304 + 64 * (j))
#define XB_TOP      3328
#define XB_TOPGEN   3392
#define XCD_BAR_WORDS 3456
#define XB_SPIN_CAP (1u << 18)

__device__ __forceinline__ unsigned xb_ld(unsigned* p)              { return __hip_atomic_load(p, __ATOMIC_RELAXED, __HIP_MEMORY_SCOPE_AGENT); }
__device__ __forceinline__ unsigned xb_add(unsigned* p, unsigned v) { return __hip_atomic_fetch_add(p, v, __ATOMIC_RELAXED, __HIP_MEMORY_SCOPE_AGENT); }
__device__ __forceinline__ unsigned xb_xcc_id() { return (unsigned)__builtin_amdgcn_s_getreg((3 << 11) | 20) & 0xFu; }
#define XB_SPIN(cond, bar) do { unsigned _sp = 0; while (cond) { __builtin_amdgcn_s_sleep(1); \
    if ((++_sp & 255u) == 0u) { if (xb_ld(&(bar)[XB_TMO])) break; if (_sp > XB_SPIN_CAP) { atomicAdd(&(bar)[XB_TMO], 1u); break; } } } } while (0)

struct XcdBarrier {
    unsigned* bar; unsigned x;
    volatile LAS unsigned* st;
};

__device__ __forceinline__ XcdBarrier xcd_barrier_post(unsigned* bar, volatile LAS unsigned* st) {
    XcdBarrier b; b.bar = bar; b.x = xb_xcc_id(); b.st = st;
    if (threadIdx.x == 0) (void)xb_add(&bar[XB_XCNT(b.x)], 1u);
    return b;
}
__device__ __forceinline__ void xcd_barrier_complete(unsigned* bar, unsigned x, unsigned& nloc, unsigned& nx) {
    const unsigned G = gridDim.x * gridDim.y * gridDim.z;
    unsigned sum, cnt, mine, sp = 0u;
    for (;;) {
        sum = 0u; cnt = 0u; mine = 0u;
#pragma unroll
        for (unsigned j = 0; j < 16; ++j) { const unsigned c = xb_ld(&bar[XB_XCNT(j)]); sum += c; cnt += (c > 0u) ? 1u : 0u; mine = (j == x) ? c : mine; }
        if (sum == G) break;
        __builtin_amdgcn_s_sleep(1);
        if ((++sp & 255u) == 0u) { if (xb_ld(&bar[XB_TMO])) break; if (sp > XB_SPIN_CAP) { atomicAdd(&bar[XB_TMO], 1u); break; } }
    }
    nloc = mine > 0u ? mine : 1u; nx = cnt > 0u ? cnt : 1u;
}

__device__ __forceinline__ void xcd_barrier(const XcdBarrier& b) {
    asm volatile("s_waitcnt vmcnt(0)" ::: "memory");
    __syncthreads();
    if (threadIdx.x == 0) {
        unsigned* bar = b.bar;
        __builtin_amdgcn_s_waitcnt(0);
        unsigned nloc = b.st[0], nx = b.st[1];
        if (nloc == 0u) { xcd_barrier_complete(bar, b.x, nloc, nx); b.st[0] = nloc; b.st[1] = nx; }
        const unsigned old = xb_add(&bar[XB_XSUB(b.x)], 1u);
        const unsigned gen = old / nloc;
        if (old + 1u == (gen + 1u) * nloc) {
            __builtin_amdgcn_fence(__ATOMIC_RELEASE, "agent");
            asm volatile("s_waitcnt vmcnt(0)" ::: "memory");
            const unsigned og = xb_add(&bar[XB_TOP], 1u);
            const unsigned tg = og / nx;
            if (og + 1u == (tg + 1u) * nx) xb_add(&bar[XB_TOPGEN], 1u);
            else XB_SPIN(xb_ld(&bar[XB_TOPGEN]) == tg, bar);
            __builtin_amdgcn_fence(__ATOMIC_ACQUIRE, "agent");
            xb_add(&bar[XB_XGEN(b.x)], 1u);
            asm volatile("s_waitcnt vmcnt(0)" ::: "memory");
        } else {
            XB_SPIN(xb_ld(&bar[XB_XGEN(b.x)]) == gen, bar);
            __builtin_amdgcn_fence(__ATOMIC_ACQUIRE, "agent");
            asm volatile("s_waitcnt vmcnt(0)" ::: "memory");
        }
    }
    __syncthreads();
}

struct Args { const float* in[13]; float* out; unsigned char* ws; };
struct Ctx { LAS unsigned char* lds; int tid, lane, wave, G, bx, gw, ngw; unsigned char* ws; float* X32; const float* in[13]; };

#define GRID_SYNC() xcd_barrier(bar)

template <int OP, int V, bool FIRST>
__device__ __forceinline__ void phase(const Ctx& C) {
    unsigned char* ws = C.ws; LAS unsigned char* lds = C.lds;
    int lane_ = C.lane; asm volatile("" : "+v"(lane_));
    const int lane = lane_, wave = C.wave, G = C.G, bx = C.bx, gw = C.gw, ngw = C.ngw;
    float* X32 = C.X32;
    bf16* XN = (bf16*)(ws + WS_XN);
    bf16* HB = (bf16*)(ws + WS_BIG);
    bf16* QB = (bf16*)(ws + WS_Q); bf16* KB = (bf16*)(ws + WS_K); bf16* VB = (bf16*)(ws + WS_V);
    bf16* OP4 = (bf16*)(ws + WS_OP4); bf16* OP16 = (bf16*)C.X32;
    float* LSE4 = (float*)(ws + WS_LSE4); float* LSE16 = (float*)(ws + WS_LSE16);
    bf16* KSH = (bf16*)(ws + WS_KVSH); bf16* VSH = KSH + (size_t)M * 256;
    bf16* OB = (bf16*)C.X32;
    if constexpr (OP == 0) {
        LAS float* scr = (LAS float*)(lds + wave * 16384);
        {
            const TIn tin{C.in[1], C.in[2], C.in[3], C.in[4], C.in[7], C.in[8], C.in[9], C.in[10], C.in[12]};
            f32x4 va[8], vb[8]; TDesc da, db; int it = gw;
            if (it < T_TOTAL) { da = t_decode(tin, ws, it); t_load(da, va, lane); }
            while (it < T_TOTAL) {
                const int it2 = it + ngw;
                if (it2 < T_TOTAL) { db = t_decode(tin, ws, it2); t_load(db, vb, lane); }
                t_store(da, va, scr, lane);
                if (it2 >= T_TOTAL) break;
                const int it3 = it2 + ngw;
                if (it3 < T_TOTAL) { da = t_decode(tin, ws, it3); t_load(da, va, lane); }
                t_store(db, vb, scr, lane);
                it = it3;
            }
        }
        const float* x_in = C.in[0];
        const size_t nchunk = (size_t)M * DM / 8, gt = (size_t)bx * (NWAVES * 64) + C.tid, ngt = (size_t)G * NWAVES * 64;
        static_assert(((size_t)M * DM / 8) % ((size_t)256 * NWAVES * 64 * 4) == 0, "x conversion: four chunks per thread per trip on a 256-workgroup grid");
        for (size_t c = gt; c < nchunk; c += 4 * ngt) {
            f32x4 a[4], b[4];
#pragma unroll
            for (int u = 0; u < 4; ++u) { const size_t cc = c + u * ngt; if (cc < nchunk) { a[u] = __builtin_nontemporal_load((const f32x4*)x_in + 2 * cc); b[u] = __builtin_nontemporal_load((const f32x4*)x_in + 2 * cc + 1); } }
#pragma unroll
            for (int u = 0; u < 4; ++u) { const size_t cc = c + u * ngt; if (cc < nchunk) {
                v4u w; w.x = pk2(a[u].x, a[u].y); w.y = pk2(a[u].z, a[u].w); w.z = pk2(b[u].x, b[u].y); w.w = pk2(b[u].z, b[u].w); ((v4u*)XN)[cc] = w; } }
        }
    } else if constexpr (OP == 1) {
        pg8::Gemm g{XN, (const bf16*)(ws + WS_WIN + (size_t)V * WIN_BYTES), M, 2 * DFF, DM}; pg8::StaticOrder S; S.init(M, 2 * DFF, G, bx);
        pg8::EpiSwiglu E{HB, DFF};
        pg8::gemm_phase<pg8::EpiSwiglu, pg8::StaticOrder, true, true>(lds, g, S, E);
    } else if constexpr (OP == 2) {
        pg8::StaticOrder S; S.init(M, DM, G, bx);
        pg8::EpiBf16 E{OP4, DM, 0, 0};
        if constexpr (V < 4) { pg8::Gemm g{HB, (const bf16*)(ws + WS_WOUT + (size_t)V * WOUT_BYTES), M, DM, DFF};
            pg8::gemm_phase<pg8::EpiBf16, pg8::StaticOrder, true, true>(lds, g, S, E);
        } else { pg8::Gemm g{OB, (const bf16*)(ws + (V == 4 ? WS_WAO : WS_WBO)), M, DM, DM};
            pg8::gemm_phase<pg8::EpiBf16, pg8::StaticOrder, true, true>(lds, g, S, E); }
    } else if constexpr (OP == 3) {
        const float* lg = C.in[5] + (size_t)V * DM; const float* lb = C.in[6] + (size_t)V * DM;
        const float scale = (V % 3 == 1) ? 1.0f : 0.5f; unsigned* XL = (unsigned*)(ws + WS_XL);
        for (int m = gw * 4; m < M; m += ngw * 4) ln_rows4<FIRST, V == 5>(C.in[0] + (size_t)m * DM, OP4 + (size_t)m * DM, scale, X32 + (size_t)m * DM, XN + (size_t)m * DM, XL + (size_t)m * 128, lg, lb, lane);
    } else if constexpr (OP == 4) {
        if constexpr (V == 0) { pg8::Gemm g{XN, (const bf16*)(ws + WS_WQKV), M, 3 * DM, DM}; pg8::StaticOrder S; S.init(M, 3 * DM, G, bx);
            pg8::EpiHeads E{QB, (size_t)M * HD, att::SC2, 16};
            pg8::gemm_phase<pg8::EpiHeads, pg8::StaticOrder, true, true>(lds, g, S, E);
        } else if constexpr (V == 1) { pg8::Gemm g{XN, (const bf16*)(ws + WS_WKV), M, 512, DM}; pg8::StaticOrder S; S.init(M, 512, G, bx);
            pg8::EpiHeads E{KSH, (size_t)M * HD, 1.0f, 0};
            pg8::gemm_phase<pg8::EpiHeads, pg8::StaticOrder, true, true>(lds, g, S, E);
        } else { pg8::Gemm g{XN, (const bf16*)(ws + WS_WBQ), M, DM, DM}; pg8::StaticOrder S; S.init(M, DM, G, bx);
            pg8::EpiHeads E{QB, (size_t)M * HD, att::SC2, 16};
            pg8::gemm_phase<pg8::EpiHeads, pg8::StaticOrder, true, true>(lds, g, S, E); }
    } else {
        int tid_ = C.tid; asm volatile("" : "+v"(tid_));
        if constexpr (V == 0) att::wg_attention<0>(lds, tid_, G, bx, QB, KB, VB, OB, OP4, OP16, LSE4, LSE16, nullptr);
        else if constexpr (V == 1) att::wg_attention<1>(lds, tid_, G, bx, QB, KB, VB, OB, OP4, OP16, LSE4, LSE16, nullptr);
        else att::wg_attention<2>(lds, tid_, G, bx, QB, KSH, VSH, OB, OP4, OP16, LSE4, LSE16, C.in[11]);
    }
}

__global__ void __launch_bounds__(NWAVES * 64, 2) yoco_fwd(Args args) {
    extern __shared__ __attribute__((aligned(16))) unsigned char lds_raw[];
    cg::grid_group grid = cg::this_grid();
    Ctx C;
    C.lds = (LAS unsigned char*)lds_raw;
    C.tid = threadIdx.x; C.lane = C.tid & 63; C.wave = __builtin_amdgcn_readfirstlane(C.tid >> 6);
    C.G = gridDim.x; C.bx = blockIdx.x; C.gw = C.bx * NWAVES + C.wave; C.ngw = C.G * NWAVES;
    C.ws = args.ws; C.X32 = args.out;
#pragma unroll
    for (int i = 0; i < 13; ++i) C.in[i] = args.in[i];
    volatile LAS unsigned* misc = (volatile LAS unsigned*)(C.lds + LDS_BYTES - 64);
    if (C.tid < 16) misc[C.tid] = 0u;
    __syncthreads();
    XcdBarrier bar = xcd_barrier_post((unsigned*)(args.ws + WS_CTL) + 4096, misc + 8);
#define PH(op, v, first) phase<op, v, first>(C); GRID_SYNC();
    if (args.out == nullptr) grid.sync();
    PH(0, 0, false)
    PH(1, 0, false) PH(2, 0, false) PH(3, 0, true)
    PH(4, 0, false) PH(5, 0, false) PH(5, 1, false) PH(2, 4, false) PH(3, 1, false)
    PH(1, 2, false) PH(2, 2, false) PH(3, 2, false)
    phase<4, 1, false>(C);
    PH(1, 1, false) PH(2, 1, false) PH(3, 3, false)
    PH(4, 2, false) PH(5, 2, false) PH(2, 5, false) PH(3, 4, false)
    PH(1, 3, false) PH(2, 3, false)
    phase<3, 5, false>(C);
#undef PH
}

static_assert(att::WG_LDS_END + 64 <= LDS_BYTES, "attention LDS map");

extern "C" void kernel_launch(void* const* d_in, const int* in_sizes, int n_in, void* d_out, int out_size, void* d_ws, size_t ws_size, hipStream_t stream) {
    static int grid = 0;
    if (grid == 0) {
        if (n_in != 13 || in_sizes[0] != M * DM || out_size != M * DM || ws_size < WS_END) { fprintf(stderr, "kernel_launch: unexpected shapes / workspace (n_in %d, ws %zu, need %zu)\n", n_in, ws_size, (size_t)WS_END); grid = -1; return; }
        int dev = 0, cus = 0, per_cu = 0;
        hipGetDevice(&dev); hipDeviceGetAttribute(&cus, hipDeviceAttributeMultiprocessorCount, dev);
        if (hipFuncSetAttribute((const void*)yoco_fwd, hipFuncAttributeMaxDynamicSharedMemorySize, LDS_BYTES) != hipSuccess) { fprintf(stderr, "kernel_launch: hipFuncSetAttribute failed\n"); grid = -1; return; }
        hipOccupancyMaxActiveBlocksPerMultiprocessor(&per_cu, (const void*)yoco_fwd, NWAVES * 64, LDS_BYTES);
        (void)hipGetLastError();
        if (per_cu < 1) { fprintf(stderr, "kernel_launch: occupancy query says %d blocks per CU\n", per_cu); }
        grid = cus;
    }
    if (grid < 0) return;
    if (hipMemsetAsync((char*)d_ws + WS_CTL, 0, 65536, stream) != hipSuccess) { fprintf(stderr, "kernel_launch: memset of the control words failed\n"); return; }
    Args a{};
    for (int i = 0; i < 13; ++i) a.in[i] = (const float*)d_in[i];
    a.out = (float*)d_out; a.ws = (unsigned char*)d_ws;
    void* kargs[] = {&a};
    hipError_t e = hipLaunchCooperativeKernel((const void*)yoco_fwd, dim3(grid), dim3(NWAVES * 64), kargs, LDS_BYTES, stream);
    if (e != hipSuccess) fprintf(stderr, "cooperative launch failed: %s (grid %d)\n", hipGetErrorString(e), grid);
}
```
